# Optimizing an MI355X kernel written in HIP

```python
import jax, jax.numpy as jnp
from jax import lax
import numpy as np

D_MODEL = 1024
BATCH = 16
SEQ = 4096
DEPTH = 1

CHUNK = 64
MIX_W = D_MODEL
POOL_W = MIX_W // 2
CONV_W = MIX_W - POOL_W
POOL_WINDOWS = (2, 4, 8, 16)
N_POOL_GROUPS = len(POOL_WINDOWS)
POOL_GROUP_W = POOL_W // N_POOL_GROUPS
N_CONV_GROUPS = 4
CONV_K = 3
IN_PROJ_W = POOL_W + 3 * CONV_W
MEM_LEN = 256
N_XHEADS = 4
XHEAD_DIM = D_MODEL // N_XHEADS
N_EXPERTS = 32
TOP_K = 4
D_FF = D_MODEL
SWIGLU_LIMIT = 7.0
SWIGLU_ALPHA = 1.702
EXPERT_BLOCK = 256
RMS_EPS = 1e-5

kernel_name = "hybrid_pool_conv_xattn_moe_encoder"


def rmsnorm(x, g):
    xf = x.astype(jnp.float32)
    y = xf * lax.rsqrt(jnp.mean(xf * xf, axis=-1, keepdims=True) + RMS_EPS)
    return (y * g.astype(jnp.float32)).astype(x.dtype)


def pool_mixer(u, w_pool, pool_scale):
    b, s, _ = u.shape
    ug = u.reshape(b, s, N_POOL_GROUPS, POOL_GROUP_W)
    cs = jnp.cumsum(ug.astype(jnp.float32), axis=1)
    pos = jnp.arange(1, s + 1, dtype=jnp.float32)
    outs = []
    for g, w in enumerate(POOL_WINDOWS):
        c = cs[:, :, g]
        prev = jnp.pad(c, ((0, 0), (w, 0), (0, 0)))[:, :s]
        cnt = jnp.minimum(pos, float(w))[None, :, None]
        outs.append((c - prev) / cnt - ug[:, :, g].astype(jnp.float32))
    d = jnp.stack(outs, axis=2).astype(u.dtype)
    y = jnp.einsum('bsgc,gcd->bsgd', d, w_pool).reshape(b, s, POOL_W)
    return y * pool_scale


def gated_short_conv(gb, gc, v, conv_w):
    z = gc * v
    rhs = conv_w[:, None, :]
    zc = lax.conv_general_dilated(z, rhs, window_strides=(1,), padding=[(CONV_K - 1, 0)],
                                  dimension_numbers=('NWC', 'WIO', 'NWC'),
                                  feature_group_count=CONV_W)
    return gb * zc


def mem_cross_attention(hn, mn, w_q, w_k, w_v, w_o):
    b, s, _ = hn.shape
    m = mn.shape[1]
    q = (hn @ w_q).reshape(b, s, N_XHEADS, XHEAD_DIM)
    k = (mn @ w_k).reshape(b, m, N_XHEADS, XHEAD_DIM)
    v = (mn @ w_v).reshape(b, m, N_XHEADS, XHEAD_DIM)
    sc = jnp.einsum('bshd,bmhd->bhsm', q, k).astype(jnp.float32) * (XHEAD_DIM ** -0.5)
    p = jax.nn.softmax(sc, axis=-1).astype(v.dtype)
    o = jnp.einsum('bhsm,bmhd->bshd', p, v).reshape(b, s, D_MODEL)
    return o @ w_o


def routed_experts(hn, w_router, b_router, w_gate_up, b_gate_up, w_down, b_down):
    b, s, d = hn.shape
    t = b * s
    xt = hn.reshape(t, d)
    logits = xt.astype(jnp.float32) @ w_router.astype(jnp.float32) + b_router.astype(jnp.float32)
    top_val, top_idx = lax.top_k(logits, TOP_K)
    gates = jax.nn.softmax(top_val, axis=-1)
    a = t * TOP_K
    flat_e = top_idx.reshape(a).astype(jnp.int32)
    flat_tok = jnp.repeat(jnp.arange(t, dtype=jnp.int32), TOP_K)
    flat_gate = gates.reshape(a)
    order = jnp.argsort(flat_e)
    sorted_e = flat_e[order]
    counts = jnp.bincount(flat_e, length=N_EXPERTS).astype(jnp.int32)
    starts = jnp.cumsum(counts) - counts
    padded = ((counts + EXPERT_BLOCK - 1) // EXPERT_BLOCK) * EXPERT_BLOCK
    pstarts = jnp.cumsum(padded) - padded
    rank = jnp.arange(a, dtype=jnp.int32) - starts[sorted_e]
    dest = pstarts[sorted_e] + rank
    p_len = a + N_EXPERTS * EXPERT_BLOCK
    n_blocks = p_len // EXPERT_BLOCK
    tok_buf = jnp.zeros((p_len,), jnp.int32).at[dest].set(flat_tok[order])
    gate_buf = jnp.zeros((p_len,), jnp.float32).at[dest].set(flat_gate[order])
    block_start = jnp.arange(n_blocks, dtype=jnp.int32) * EXPERT_BLOCK
    block_e = jnp.clip(jnp.searchsorted(pstarts, block_start, side='right') - 1, 0, N_EXPERTS - 1).astype(jnp.int32)

    def block_step(acc, blk):
        tok, g, e = blk
        xb = xt[tok]
        gu = xb @ w_gate_up[e] + b_gate_up[e]
        x_glu = jnp.minimum(gu[:, :D_FF], SWIGLU_LIMIT)
        x_lin = jnp.clip(gu[:, D_FF:], -SWIGLU_LIMIT, SWIGLU_LIMIT)
        act = (x_lin + 1) * (x_glu * jax.nn.sigmoid(SWIGLU_ALPHA * x_glu))
        y = act @ w_down[e] + b_down[e]
        acc = acc.at[tok].add((y.astype(jnp.float32) * g[:, None]).astype(acc.dtype))
        return acc, None

    acc, _ = lax.scan(block_step, jnp.zeros_like(xt),
                      (tok_buf.reshape(n_blocks, EXPERT_BLOCK),
                       gate_buf.reshape(n_blocks, EXPERT_BLOCK), block_e))
    return acc.reshape(b, s, d)


def setup_inputs(seed: int = 0) -> dict:
    key = jax.random.key(seed)
    ks = jax.random.split(key, 24)
    f32 = jnp.float32
    nrm = lambda k, shape, scale: jax.random.normal(k, shape, f32) * scale
    gain = lambda k, shape: 1.0 + 0.05 * jax.random.normal(k, shape, f32)
    L = DEPTH
    return {
        "x": jax.random.normal(ks[0], (BATCH, SEQ, D_MODEL), f32),
        "mem": jax.random.normal(ks[1], (BATCH, MEM_LEN, D_MODEL), f32),
        "g_mix": gain(ks[2], (L, D_MODEL)),
        "w_in": nrm(ks[3], (L, D_MODEL, IN_PROJ_W), D_MODEL ** -0.5),
        "w_pool": nrm(ks[4], (L, N_POOL_GROUPS, POOL_GROUP_W, POOL_GROUP_W), POOL_GROUP_W ** -0.5),
        "pool_scale": 1.0 + 0.1 * jax.random.normal(ks[5], (L, POOL_W), f32),
        "conv_w": nrm(ks[6], (L, CONV_K, CONV_W), CONV_K ** -0.5),
        "w_out": nrm(ks[7], (L, MIX_W, D_MODEL), MIX_W ** -0.5),
        "g_xattn": gain(ks[8], (L, D_MODEL)),
        "g_mem": gain(ks[9], (L, D_MODEL)),
        "w_q": nrm(ks[10], (L, D_MODEL, D_MODEL), D_MODEL ** -0.5),
        "w_k": nrm(ks[11], (L, D_MODEL, D_MODEL), D_MODEL ** -0.5),
        "w_v": nrm(ks[12], (L, D_MODEL, D_MODEL), D_MODEL ** -0.5),
        "w_o": nrm(ks[13], (L, D_MODEL, D_MODEL), D_MODEL ** -0.5),
        "g_moe": gain(ks[14], (L, D_MODEL)),
        "w_router": nrm(ks[15], (L, D_MODEL, N_EXPERTS), D_MODEL ** -0.5),
        "b_router": nrm(ks[16], (L, N_EXPERTS), 0.01),
        "w_gate_up": nrm(ks[17], (L, N_EXPERTS, D_MODEL, 2 * D_FF), D_MODEL ** -0.5),
        "b_gate_up": nrm(ks[18], (L, N_EXPERTS, 2 * D_FF), 0.01),
        "w_down": nrm(ks[19], (L, N_EXPERTS, D_FF, D_MODEL), D_FF ** -0.5),
        "b_down": nrm(ks[20], (L, N_EXPERTS, D_MODEL), 0.01),
        "g_final": gain(ks[21], (D_MODEL,)),
    }


def reference(x, mem, g_mix, w_in, w_pool, pool_scale, conv_w, w_out,
              g_xattn, g_mem, w_q, w_k, w_v, w_o,
              g_moe, w_router, b_router, w_gate_up, b_gate_up, w_down, b_down,
              g_final):
    h = x
    for l in range(DEPTH):
        hn = rmsnorm(h, g_mix[l])
        proj = hn @ w_in[l]
        u = proj[..., :POOL_W]
        gb = proj[..., POOL_W:POOL_W + CONV_W]
        gc = proj[..., POOL_W + CONV_W:POOL_W + 2 * CONV_W]
        v = proj[..., POOL_W + 2 * CONV_W:]
        y_pool = pool_mixer(u, w_pool[l], pool_scale[l])
        y_conv = gated_short_conv(gb, gc, v, conv_w[l])
        h = h + jnp.concatenate([y_pool, y_conv], axis=-1) @ w_out[l]
        h = h + mem_cross_attention(rmsnorm(h, g_xattn[l]), rmsnorm(mem, g_mem[l]),
                                    w_q[l], w_k[l], w_v[l], w_o[l])
        h = h + routed_experts(rmsnorm(h, g_moe[l]), w_router[l], b_router[l],
                               w_gate_up[l], b_gate_up[l], w_down[l], b_down[l])
    return rmsnorm(h, g_final)
```

```cpp
#include <hip/hip_runtime.h>
#include <cstdio>
#include <cstdint>

#ifndef MK_N_LAUNCHES
#define MK_N_LAUNCHES 1
#endif

#define LAS __attribute__((address_space(3)))
#define GAS __attribute__((address_space(1)))
typedef unsigned short bf16_t;
typedef short bf16x8 __attribute__((ext_vector_type(8)));
typedef float f32x4 __attribute__((ext_vector_type(4)));
typedef float f32x2 __attribute__((ext_vector_type(2)));
typedef unsigned u32x4 __attribute__((ext_vector_type(4)));
typedef unsigned u32x2 __attribute__((ext_vector_type(2)));
typedef unsigned u32x6 __attribute__((ext_vector_type(6)));
typedef float f32x16 __attribute__((ext_vector_type(16)));

constexpr int D = 1024, BATCH = 16, SEQ = 4096, MTOK = BATCH * SEQ, MEMLEN = 256, MROWS = BATCH * MEMLEN;
constexpr int NHEAD = 4, HDIM = 256, NEXP = 32, TOPK = 4, DFF = 1024, INW = 2048, POOLW = 512, CONVW = 512;
constexpr int PROJW = POOLW + 2 * CONVW;
constexpr float RMS_EPS = 1e-5f;
constexpr int NWAVES = 8, NTHREADS = 512;
constexpr float GLU_C = 1.702f * 1.4426950408889634f;
constexpr float W8_SCALE = 32.0f, W8_INV = 1.0f / 32.0f;
constexpr int K6B = D * 3 / 4;
constexpr float H6_SCALE = 1.7f, W6_TARGET = 1.6f;
constexpr int MAXSLOTS = MTOK * TOPK + NEXP * 256;

constexpr size_t MiB = 1u << 20;
constexpr size_t WS_CTL = 0, CTL_ZERO_BYTES = 64 * 1024;
constexpr size_t WS_SS1 = 1 * MiB;
constexpr size_t WS_RSTD2 = 5 * MiB;
constexpr size_t WS_RSTD0 = 5 * MiB + 512 * 1024;
constexpr size_t WS_ETOK = 6 * MiB;
constexpr size_t WS_GTOK = 7 * MiB;
constexpr size_t WS_SLOT_OF_TOK = 8 * MiB;
constexpr size_t WS_TOK_OF_SLOT = 9 * MiB;
constexpr size_t WS_GATE_OF_SLOT = 11 * MiB;
constexpr size_t WS_CNT = 13 * MiB;
constexpr size_t WS_PSTART = 13 * MiB + 64 * 1024;
constexpr size_t WS_SW6 = 13 * MiB + 64 * 1024 + 1024;
constexpr size_t WS_WRT = 13 * MiB + 512 * 1024;
constexpr size_t WS_WPB = 14 * MiB;
constexpr size_t WS_RS_SLOT = 14 * MiB + 512 * 1024;
constexpr size_t WS_WD = 16 * MiB;
constexpr size_t WS_WGU = 48 * MiB;
constexpr size_t WS_H2B = 112 * MiB;
constexpr size_t WS_Y = 176 * MiB;
constexpr size_t WS_ACT = 440 * MiB;
constexpr size_t WS_H1B = 704 * MiB;
constexpr size_t WS_XN = 176 * MiB;
constexpr size_t WS_PROJ = 304 * MiB;
constexpr size_t WS_H1Q = 560 * MiB;
constexpr size_t WS_DP = 624 * MiB;
constexpr size_t WS_MIXA = 832 * MiB;
constexpr size_t WS_MT = 304 * MiB;
constexpr size_t WS_NT = 336 * MiB;
constexpr size_t WS_P = 432 * MiB;
constexpr size_t WS_MN = 960 * MiB;
constexpr size_t WS_KV = 968 * MiB;
constexpr size_t WS_WIN = 984 * MiB;
constexpr size_t WS_WOUT = 988 * MiB;
constexpr size_t WS_WQ = 990 * MiB, WS_WK = 992 * MiB, WS_WV = 994 * MiB, WS_WO = 996 * MiB;
constexpr size_t WS_WC = 998 * MiB;
constexpr size_t WS_END = 1000 * MiB;
static_assert(WS_Y + (size_t)MAXSLOTS * 1024 <= WS_ACT && WS_ACT + (size_t)MAXSLOTS * 1024 <= WS_H1B && WS_H1B + 128 * MiB <= WS_MIXA && WS_RS_SLOT + (size_t)MAXSLOTS * 4 <= WS_WD, "d_ws map");
constexpr float P8_SCALE = 256.0f, P8_INV = 1.0f / 256.0f;
constexpr float Y8_SCALE = 4.0f, Y8_INV = 0.25f;

constexpr int RING_BYTES = 131072;
constexpr int XCH_OFF = RING_BYTES;
constexpr int MISC_OFF = RING_BYTES + 8192;
constexpr int LDS_BYTES = 147456;

__device__ __forceinline__ unsigned cvt_pk_bf16(float lo, float hi) { unsigned r; asm volatile("v_cvt_pk_bf16_f32 %0, %1, %2" : "=v"(r) : "v"(lo), "v"(hi)); return r; }
__device__ __forceinline__ unsigned pk4_fp8(float a, float b, float c, float d) { int w = 0; w = __builtin_amdgcn_cvt_pk_fp8_f32(a, b, w, false); w = __builtin_amdgcn_cvt_pk_fp8_f32(c, d, w, true); return (unsigned)w; }
__device__ __forceinline__ float bf2f(unsigned short v) { return __uint_as_float(((unsigned)v) << 16); }
__device__ __forceinline__ float bflo(unsigned w) { return __uint_as_float(w << 16); }
__device__ __forceinline__ float bfhi(unsigned w) { return __uint_as_float(w & 0xffff0000u); }
__device__ __forceinline__ float wave_sum(float v) {
#pragma unroll
    for (int o = 1; o < 64; o <<= 1) v += __shfl_xor(v, o);
    return v;
}
#define LDS_WAIT() asm volatile("s_waitcnt lgkmcnt(0)" ::: "memory")
#define VM_WAIT() asm volatile("s_waitcnt vmcnt(0)" ::: "memory")

namespace pg8 {
constexpr int BM = 256, BK = 64, HALF = 128, HTB = HALF * BK * 2, STAGE_BYTES = 8 * HTB, NXCD = 8, WGM = 8;
__host__ __device__ __forceinline__ int lds_byte(int r, int c) { const int st = (r >> 4) * 2 + (c >> 5), rr = r & 15, cc = c & 31, ob = rr * 64 + cc * 2; return st * 1024 + (ob ^ (((ob >> 9) & 1) << 5)); }
__host__ __device__ __forceinline__ void stage_rc(int b, int& R, int& C) { const int st = b / 1024, sb = b % 1024, swz = sb ^ (((sb >> 9) & 1) << 5); R = (st >> 1) * 16 + swz / 64; C = (st & 1) * 32 + (swz % 64) / 2; }
__host__ __device__ __forceinline__ int perm32(int rho) { const int n = rho >> 4, i = rho & 15; return 8 * (i >> 2) + 4 * n + (i & 3); }

struct Unit { unsigned a, b; char* o; int pm, pn, ex; };

__device__ __forceinline__ bool static_order(int i, int G, int c, int nM, int nN, int& pm, int& pn) {
    const int nwg = nM * nN; const long L = (long)i * G + c; if (L >= nwg) return false;
    int wgid = (int)L; { const int q = nwg / NXCD, r = nwg % NXCD, xcd = wgid % NXCD, off = wgid / NXCD; wgid = (xcd < r ? xcd * (q + 1) : r * (q + 1) + (xcd - r) * q) + off; }
    const int nig = WGM * nN, gid = wgid / nig, fm = gid * WGM, gsz = (nM - fm) < WGM ? (nM - fm) : WGM;
    pm = fm + ((wgid % nig) % gsz); pn = (wgid % nig) / gsz; return true;
}

typedef int v4i_t __attribute__((ext_vector_type(4)));
typedef int v8i_t __attribute__((ext_vector_type(8)));
template <class Epi, class Sched, bool GATHER, bool ALIGN_EPI, bool SP2, bool F8 = false, bool F6 = false>
__device__ __forceinline__ void gemm_phase(LAS unsigned char* lds, const void* Abase, const void* Bbase, const int KB, const int lda2, const int ldb2, const int* gidx, const Sched& S, const Epi& E) {
    int tid_ = threadIdx.x; asm volatile("" : "+v"(tid_));
    const int tid = tid_, wid = __builtin_amdgcn_readfirstlane(tid >> 6), lane = tid & 63, wr = wid >> 2, wc = wid & 3, fr = lane & 15, fq = lane >> 4;
    const int nt = KB / (F6 ? 96 : BK * 2);
    constexpr int HT_ = HTB, PIECE_ = 8192, FSTEP_ = 2048;
    unsigned voffA, voffB, vG[4], vN[4], vS[4]; int gR = 0; unsigned gC = 0u;
    { int R, C; stage_rc(tid * 16, R, C); int Cb = C * 2;
      if constexpr (F6) { const int Le = lane - (wid & 1), Lc = (Le >= 0 && Le < 48) ? Le : 0, u_ = Lc / 3, p_ = Lc - 3 * u_; R = wid * 8 + (u_ >> 1); Cb = (3 * (u_ & 1) + p_) * 16; }
      const int Rb = (R & ~31) + perm32(R & 31); voffB = (unsigned)(Rb * ldb2 + Cb); voffA = (unsigned)(R * lda2 + Cb); gR = R; gC = (unsigned)Cb; }
#define PG8_LOADROWS_RAW(v, pm_) do { _Pragma("unroll") for (int _p = 0; _p < 4; ++_p) v[_p] = (unsigned)gidx[(pm_) * 256 + gR + 64 * _p]; } while (0)
#define PG8_ROWOFF(raw) ((raw) * (unsigned)lda2 + gC)
    const unsigned pstepA = GATHER ? 0u : 64u * (unsigned)lda2, pstepB = 64u * (unsigned)ldb2;
    const unsigned kstep = F6 ? 96u : (unsigned)(BK * 2);
    const unsigned hstepA = GATHER ? 0u : (unsigned)HALF * lda2, hstepB = (unsigned)HALF * ldb2;
    const __amdgpu_buffer_rsrc_t rsA = __builtin_amdgcn_make_buffer_rsrc((void*)Abase, 0, -1, 0x00020000), rsB = __builtin_amdgcn_make_buffer_rsrc((void*)Bbase, 0, -1, 0x00020000);
    const unsigned ldsw = (unsigned)wid * 1024u;
    const int f6o = ((fr >> 3) & 1) * 16 + (2 * (fr & 7) + (fq >> 1)) * 48 + (fq & 1) * 24;
    const int aoff = F6 ? (wr * 8 + (fr >> 3)) * 1024 + f6o : lds_byte(wr * 64 + fr, fq * 8), boff = F6 ? (wc * 4 + (fr >> 3)) * 1024 + f6o : lds_byte(wc * 32 + fr, fq * 8);
    constexpr int KOFF = 1024;
    int f8scale = 0x7f7f7f7f; if constexpr (F8 || F6) asm volatile("" : "+v"(f8scale));
#define PG8_SA(b, h) (((b) * 2 + (h)) * HT_)
#define PG8_SB(b, h) ((4 + (b) * 2 + (h)) * HT_)
#define PG8_STAGE_B(bufoff, soff) do { _Pragma("unroll") for (int _i = 0; _i < 2; ++_i) \
        { if constexpr (false) __builtin_amdgcn_raw_ptr_buffer_load_lds(rsB, (LAS void*)(lds + (bufoff) + ldsw + _i * PIECE_), 12, voffB, (soff) + _i * pstepB, 0, 0); else __builtin_amdgcn_raw_ptr_buffer_load_lds(rsB, (LAS void*)(lds + (bufoff) + ldsw + _i * PIECE_), 16, voffB, (soff) + _i * pstepB, 0, 0); } } while (0)
#define PG8_STAGE_A(bufoff, soff, h) do { _Pragma("unroll") for (int _i = 0; _i < 2; ++_i) \
        { if constexpr (false) __builtin_amdgcn_raw_ptr_buffer_load_lds(rsA, (LAS void*)(lds + (bufoff) + ldsw + _i * PIECE_), 12, GATHER ? vG[2 * (h) + _i] : voffA, (soff) + (h) * hstepA + _i * pstepA, 0, 0); else __builtin_amdgcn_raw_ptr_buffer_load_lds(rsA, (LAS void*)(lds + (bufoff) + ldsw + _i * PIECE_), 16, GATHER ? vG[2 * (h) + _i] : voffA, (soff) + (h) * hstepA + _i * pstepA, 0, 0); } } while (0)
#define PG8_STAGE_AN(bufoff, soff, h, nx) do { _Pragma("unroll") for (int _i = 0; _i < 2; ++_i) \
        { if constexpr (false) __builtin_amdgcn_raw_ptr_buffer_load_lds(rsA, (LAS void*)(lds + (bufoff) + ldsw + _i * PIECE_), 12, GATHER ? vS[2 * (h) + _i] : voffA, (soff) + (h) * hstepA + _i * pstepA, 0, 0); else __builtin_amdgcn_raw_ptr_buffer_load_lds(rsA, (LAS void*)(lds + (bufoff) + ldsw + _i * PIECE_), 16, GATHER ? vS[2 * (h) + _i] : voffA, (soff) + (h) * hstepA + _i * pstepA, 0, 0); } } while (0)
#define PG8_LD6(dst, p) do { const LAS unsigned char* p_ = (p); const u32x2 x0_ = *(const volatile LAS u32x2*)p_, x1_ = *(const volatile LAS u32x2*)(p_ + 8), x2_ = *(const volatile LAS u32x2*)(p_ + 16); \
        dst = (u32x6){x0_.x, x0_.y, x1_.x, x1_.y, x2_.x, x2_.y}; } while (0)
#define PG8_LDA(dst, b, h) do { if constexpr (F6) { _Pragma("unroll") for (int m = 0; m < 4; ++m) PG8_LD6(dst##6[m], lds + PG8_SA(b, h) + aoff + m * FSTEP_); } \
        else { _Pragma("unroll") for (int m = 0; m < 4; ++m) _Pragma("unroll") for (int k = 0; k < 2; ++k) dst[m][k] = *(const LAS bf16x8*)(lds + PG8_SA(b, h) + aoff + m * 2048 + k * KOFF); } } while (0)
#define PG8_LDB(dst, b, h) do { if constexpr (F6) { _Pragma("unroll") for (int n = 0; n < 2; ++n) PG8_LD6(dst##6[n], lds + PG8_SB(b, h) + boff + n * FSTEP_); } \
        else { _Pragma("unroll") for (int n = 0; n < 2; ++n) _Pragma("unroll") for (int k = 0; k < 2; ++k) dst[n][k] = *(const LAS bf16x8*)(lds + PG8_SB(b, h) + boff + n * 2048 + k * KOFF); } } while (0)
#define PG8_CAT(x, y) __builtin_shufflevector(__builtin_bit_cast(v4i_t, x), __builtin_bit_cast(v4i_t, y), 0, 1, 2, 3, 4, 5, 6, 7)
#define PG8_MMA(ai, bj, At, Bt) do { __builtin_amdgcn_s_setprio(1); _Pragma("unroll") for (int m = 0; m < 4; ++m) _Pragma("unroll") for (int n = 0; n < 2; ++n) { \
        if constexpr (F6) { asm volatile("v_mfma_scale_f32_16x16x128_f8f6f4 %0, %1, %2, %0, %3, %3 op_sel_hi:[0,0,0] cbsz:2 blgp:2" : "+v"(acc[ai][bj][m][n]) : "v"(Bt##6[n]), "v"(At##6[m]), "v"(f8scale)); } \
        else if constexpr (F8) { const v8i_t b8_ = PG8_CAT(Bt[n][0], Bt[n][1]), a8_ = PG8_CAT(At[m][0], At[m][1]); \
            asm volatile("v_mfma_scale_f32_16x16x128_f8f6f4 %0, %1, %2, %0, %3, %3 op_sel_hi:[0,0,0]" : "+v"(acc[ai][bj][m][n]) : "v"(b8_), "v"(a8_), "v"(f8scale)); } \
        else { _Pragma("unroll") for (int k = 0; k < 2; ++k) acc[ai][bj][m][n] = __builtin_amdgcn_mfma_f32_16x16x32_bf16(Bt[n][k], At[m][k], acc[ai][bj][m][n], 0, 0, 0); } } \
        __builtin_amdgcn_s_setprio(0); } while (0)
#define PG8_WAIT_V(n) asm volatile("s_waitcnt vmcnt(" #n ")" ::: "memory")
#define PG8_WAIT_L(n) asm volatile("s_waitcnt lgkmcnt(" #n ")" ::: "memory")
#define PG8_BAR __builtin_amdgcn_s_barrier()
#define PG8_SCHED __builtin_amdgcn_sched_barrier(0)
    Unit cur, nxt; int ui = 0;
    if (!S.next(0, cur)) return;
    f32x4 acc[2][2][4][2];
#pragma unroll
    for (int a = 0; a < 2; ++a)
#pragma unroll
        for (int b = 0; b < 2; ++b)
#pragma unroll
            for (int m = 0; m < 4; ++m)
#pragma unroll
                for (int n = 0; n < 2; ++n) acc[a][b][m][n] = (f32x4){0.f, 0.f, 0.f, 0.f};
    bf16x8 At[4][2], B0[2][2], B1[2][2]; u32x6 At6[4], B06[2], B16[2];
    unsigned cA = cur.a, cB = cur.b;
    if constexpr (GATHER) { PG8_LOADROWS_RAW(vN, cur.pm); _Pragma("unroll") for (int _p = 0; _p < 4; ++_p) { vG[_p] = PG8_ROWOFF(vN[_p]); vS[_p] = vG[_p]; } } else { _Pragma("unroll") for (int _p = 0; _p < 4; ++_p) { vG[_p] = 0u; vS[_p] = 0u; vN[_p] = 0u; } }
    if constexpr (SP2) {
        PG8_STAGE_B(PG8_SB(0, 0), cB); PG8_STAGE_B(PG8_SB(0, 1), cB + hstepB); PG8_STAGE_A(PG8_SA(0, 0), cA, 0); PG8_STAGE_A(PG8_SA(0, 1), cA, 1);
        if (wr == 1) PG8_BAR;
        PG8_WAIT_V(2); PG8_BAR;
        PG8_STAGE_B(PG8_SB(1, 0), cB + kstep); PG8_STAGE_A(PG8_SA(1, 0), cA + kstep, 0); PG8_STAGE_B(PG8_SB(1, 1), cB + hstepB + kstep);
        PG8_WAIT_V(6); PG8_BAR;
    } else {
        PG8_STAGE_B(PG8_SB(0, 0), cB); PG8_STAGE_A(PG8_SA(0, 0), cA, 0); PG8_STAGE_B(PG8_SB(0, 1), cB + hstepB); PG8_STAGE_A(PG8_SA(0, 1), cA, 1);
        if (wr == 1) PG8_BAR;
        PG8_WAIT_V(4); PG8_BAR;
        PG8_STAGE_B(PG8_SB(1, 0), cB + kstep); PG8_STAGE_A(PG8_SA(1, 0), cA + kstep, 0); PG8_STAGE_B(PG8_SB(1, 1), cB + hstepB + kstep);
        PG8_WAIT_V(6); PG8_BAR;
    }
    for (;;) {
        const bool has_next = S.next(ui + 1, nxt);
        const unsigned nA = has_next ? nxt.a : cA, nB = has_next ? nxt.b : cB;
        if constexpr (GATHER) { if (has_next) { PG8_LOADROWS_RAW(vN, nxt.pm); } }
#define PG8_KITER(LAST_, a1, a2, b2) do { const unsigned a3 = (a2) + kstep, b3 = (b2) + kstep; \
            if constexpr (SP2) { \
            PG8_LDB(B0, 0, 0); PG8_LDB(B1, 0, 1); PG8_SCHED; PG8_LDA(At, 0, 0); PG8_STAGE_A(PG8_SA(1, 1), a1, 1); \
            PG8_WAIT_V(8); PG8_WAIT_L(0); PG8_BAR; PG8_MMA(0, 0, At, B0); PG8_MMA(0, 1, At, B1); PG8_BAR; PG8_SCHED; \
            PG8_LDA(At, 0, 1); PG8_STAGE_B(PG8_SB(0, 0), b2); PG8_STAGE_B(PG8_SB(0, 1), b2 + hstepB); PG8_STAGE_AN(PG8_SA(0, 0), a2, 0, LAST_); \
            PG8_WAIT_V(8); PG8_WAIT_L(0); PG8_BAR; PG8_MMA(1, 0, At, B0); PG8_MMA(1, 1, At, B1); PG8_BAR; PG8_SCHED; \
            PG8_LDB(B0, 1, 0); PG8_LDB(B1, 1, 1); PG8_SCHED; PG8_LDA(At, 1, 0); PG8_STAGE_AN(PG8_SA(0, 1), a2, 1, LAST_); \
            PG8_WAIT_V(8); PG8_WAIT_L(0); PG8_BAR; PG8_MMA(0, 0, At, B0); PG8_MMA(0, 1, At, B1); PG8_BAR; PG8_SCHED; \
            PG8_LDA(At, 1, 1); PG8_STAGE_B(PG8_SB(1, 0), b3); PG8_STAGE_B(PG8_SB(1, 1), b3 + hstepB); PG8_STAGE_AN(PG8_SA(1, 0), a3, 0, LAST_); \
            PG8_WAIT_V(8); PG8_WAIT_L(0); PG8_BAR; PG8_MMA(1, 0, At, B0); PG8_MMA(1, 1, At, B1); PG8_BAR; PG8_SCHED; \
            } else { \
            PG8_LDB(B0, 0, 0); PG8_SCHED; PG8_LDA(At, 0, 0); PG8_STAGE_A(PG8_SA(1, 1), a1, 1); \
            PG8_WAIT_L(8); PG8_BAR; PG8_WAIT_L(0); PG8_MMA(0, 0, At, B0); PG8_BAR; PG8_SCHED; \
            PG8_LDB(B1, 0, 1); PG8_STAGE_B(PG8_SB(0, 0), b2); \
            PG8_BAR; PG8_WAIT_L(0); PG8_MMA(0, 1, At, B1); PG8_BAR; \
            PG8_LDA(At, 0, 1); PG8_STAGE_AN(PG8_SA(0, 0), a2, 0, LAST_); \
            PG8_BAR; PG8_WAIT_L(0); PG8_MMA(1, 0, At, B0); PG8_BAR; PG8_SCHED; \
            PG8_STAGE_B(PG8_SB(0, 1), b2 + hstepB); \
            PG8_WAIT_V(6); PG8_BAR; PG8_MMA(1, 1, At, B1); PG8_BAR; \
            PG8_LDB(B0, 1, 0); PG8_SCHED; PG8_LDA(At, 1, 0); PG8_STAGE_AN(PG8_SA(0, 1), a2, 1, LAST_); \
            PG8_WAIT_L(8); PG8_BAR; PG8_WAIT_L(0); PG8_MMA(0, 0, At, B0); PG8_BAR; PG8_SCHED; \
            PG8_LDB(B1, 1, 1); PG8_STAGE_B(PG8_SB(1, 0), b3); \
            PG8_BAR; PG8_WAIT_L(0); PG8_MMA(0, 1, At, B1); PG8_BAR; \
            PG8_LDA(At, 1, 1); PG8_STAGE_AN(PG8_SA(1, 0), a3, 0, LAST_); \
            PG8_BAR; PG8_WAIT_L(0); PG8_MMA(1, 0, At, B0); PG8_BAR; PG8_SCHED; \
            PG8_STAGE_B(PG8_SB(1, 1), b3 + hstepB); \
            PG8_WAIT_V(6); PG8_BAR; PG8_MMA(1, 1, At, B1); PG8_BAR; \
            } \
        } while (0)
#pragma nounroll
        for (int t = 0; t < nt - 2; t += 2) { const unsigned a1_ = cA + (unsigned)(t + 1) * kstep, a2_ = cA + (unsigned)(t + 2) * kstep, b2_ = cB + (unsigned)(t + 2) * kstep; PG8_KITER(false, a1_, a2_, b2_); }
        { if constexpr (GATHER) { if (has_next) { asm volatile("; next unit's rows" : "+v"(vN[0]), "+v"(vN[1]), "+v"(vN[2]), "+v"(vN[3])); _Pragma("unroll") for (int _p = 0; _p < 4; ++_p) vS[_p] = PG8_ROWOFF(vN[_p]); } }
          const unsigned a1_ = cA + (unsigned)(nt - 1) * kstep; PG8_KITER(true, a1_, nA, nB); }
#undef PG8_KITER
        if constexpr (ALIGN_EPI) { if (wr == 0) PG8_BAR; }
        if constexpr (F8 || F6) asm volatile("s_nop 15\n\ts_nop 15" ::: "memory");
        { int fr_e = fr, fq_e = fq; asm volatile("" : "+v"(fr_e), "+v"(fq_e));
          E(acc, cur, wr, wc, fr_e, fq_e, lds + RING_BYTES, wid, lane); }
        if (!has_next) break;
#pragma unroll
        for (int a = 0; a < 2; ++a)
#pragma unroll
            for (int b = 0; b < 2; ++b)
#pragma unroll
                for (int m = 0; m < 4; ++m)
#pragma unroll
                    for (int n = 0; n < 2; ++n) acc[a][b][m][n] = (f32x4){0.f, 0.f, 0.f, 0.f};
        cur = nxt; cA = nA; cB = nB; ++ui;
        if constexpr (GATHER) { vG[0] = vS[0]; vG[1] = vS[1]; vG[2] = vS[2]; vG[3] = vS[3]; }
        if constexpr (ALIGN_EPI) { if (wr == 1) PG8_BAR; }
    }
    PG8_WAIT_V(0);
    if constexpr (!ALIGN_EPI) { if (wr == 0) PG8_BAR; }
    PG8_BAR;
#undef PG8_SA
#undef PG8_SB
#undef PG8_STAGE_A
#undef PG8_STAGE_AN
#undef PG8_LOADROWS_RAW
#undef PG8_ROWOFF
#undef PG8_STAGE_B
#undef PG8_LDA
#undef PG8_LD6
#undef PG8_LDB
#undef PG8_MMA
#undef PG8_CAT
#undef PG8_WAIT_V
#undef PG8_WAIT_L
#undef PG8_BAR
#undef PG8_SCHED
}
}
using pg8::Unit;
typedef f32x4 AccT[2][2][4][2];

#define EROW(ai, m) ((ai) * 128 + wr * 64 + (m) * 16 + fr)
#define ECOL(bj) ((bj) * 128 + wc * 32 + 8 * fq)
__device__ __forceinline__ u32x4 pack8(const f32x4 v0, const f32x4 v1) { u32x4 w; w.x = cvt_pk_bf16(v0[0], v0[1]); w.y = cvt_pk_bf16(v0[2], v0[3]); w.z = cvt_pk_bf16(v1[0], v1[1]); w.w = cvt_pk_bf16(v1[2], v1[3]); return w; }

struct EpiStore {
    int ldc;
    __device__ __forceinline__ void operator()(const AccT& acc, const Unit& u, int wr, int wc, int fr, int fq, LAS unsigned char*, int, int) const {
        bf16_t* base = (bf16_t*)u.o;
#pragma unroll
        for (int ai = 0; ai < 2; ++ai)
#pragma unroll
            for (int m = 0; m < 4; ++m) { bf16_t* rowp = base + (size_t)EROW(ai, m) * ldc + ECOL(0);
#pragma unroll
                for (int bj = 0; bj < 2; ++bj) *(u32x4*)(rowp + bj * 128) = pack8(acc[ai][bj][m][0], acc[ai][bj][m][1]); }
    }
};
struct EpiStore8 {
    int ldc;
    __device__ __forceinline__ void operator()(const AccT& acc, const Unit& u, int wr, int wc, int fr, int fq, LAS unsigned char*, int, int) const {
        unsigned char* base = (unsigned char*)u.o;
#pragma unroll
        for (int ai = 0; ai < 2; ++ai)
#pragma unroll
            for (int m = 0; m < 4; ++m) { unsigned char* rowp = base + (size_t)EROW(ai, m) * ldc + ECOL(0);
#pragma unroll
                for (int bj = 0; bj < 2; ++bj) { f32x4 v0 = acc[ai][bj][m][0], v1 = acc[ai][bj][m][1];
#pragma unroll
                    for (int q = 0; q < 4; ++q) { v0[q] = __builtin_amdgcn_fmed3f(v0[q], -440.f, 440.f); v1[q] = __builtin_amdgcn_fmed3f(v1[q], -440.f, 440.f); }
                    u32x2 q8; q8.x = pk4_fp8(v0[0], v0[1], v0[2], v0[3]); q8.y = pk4_fp8(v1[0], v1[1], v1[2], v1[3]); *(u32x2*)(rowp + bj * 128) = q8; } }
    }
};
struct EpiProj {
    bf16_t* proj; const float* rstd0;
    __device__ __forceinline__ void operator()(const AccT& acc, const Unit& u, int wr, int wc, int fr, int fq, LAS unsigned char*, int, int) const {
        const size_t r0 = (size_t)u.pm * 256;
        if (u.pn < 4) {
#pragma unroll
            for (int ai = 0; ai < 2; ++ai)
#pragma unroll
                for (int m = 0; m < 4; ++m) { const size_t row = r0 + EROW(ai, m); const float rs = rstd0[row]; bf16_t* rowp = proj + row * PROJW + u.pn * 256 + ECOL(0);
#pragma unroll
                    for (int bj = 0; bj < 2; ++bj) *(u32x4*)(rowp + bj * 128) = pack8(acc[ai][bj][m][0] * rs, acc[ai][bj][m][1] * rs); }
        } else {
#pragma unroll
            for (int ai = 0; ai < 2; ++ai)
#pragma unroll
                for (int m = 0; m < 4; ++m) { const size_t row = r0 + EROW(ai, m); const float rs = rstd0[row]; const float rs2 = rs * rs;
                    *(u32x4*)(proj + row * PROJW + 2 * CONVW + (u.pn - 4) * 128 + wc * 32 + 8 * fq) = pack8(acc[ai][0][m][0] * acc[ai][1][m][0] * rs2, acc[ai][0][m][1] * acc[ai][1][m][1] * rs2); }
        }
    }
};
struct EpiOutProj {
    const bf16_t* xb; bf16_t* h1b; float* ss1; unsigned char* h1q;
    __device__ __forceinline__ void operator()(const AccT& acc, const Unit& u, int wr, int wc, int fr, int fq, LAS unsigned char*, int, int) const {
        const size_t r0 = (size_t)u.pm * 256; const int c0 = u.pn * 256 + ECOL(0);
#pragma unroll
        for (int ai = 0; ai < 2; ++ai)
#pragma unroll
            for (int m = 0; m < 4; ++m) { const size_t row = r0 + EROW(ai, m); const size_t off = row * D + c0; float ss = 0.f;
#pragma unroll
                for (int bj = 0; bj < 2; ++bj) {
                    const u32x4 xw = *(const u32x4*)(xb + off + bj * 128); f32x4 v0 = acc[ai][bj][m][0], v1 = acc[ai][bj][m][1];
                    v0[0] += bflo(xw.x); v0[1] += bfhi(xw.x); v0[2] += bflo(xw.y); v0[3] += bfhi(xw.y); v1[0] += bflo(xw.z); v1[1] += bfhi(xw.z); v1[2] += bflo(xw.w); v1[3] += bfhi(xw.w);
                    *(u32x4*)(h1b + off + bj * 128) = pack8(v0, v1);
                    { f32x4 c0_ = v0, c1_ = v1;
#pragma unroll
                      for (int q = 0; q < 4; ++q) { c0_[q] = __builtin_amdgcn_fmed3f(c0_[q], -440.f, 440.f); c1_[q] = __builtin_amdgcn_fmed3f(c1_[q], -440.f, 440.f); }
                      u32x2 q8; q8.x = pk4_fp8(c0_[0], c0_[1], c0_[2], c0_[3]); q8.y = pk4_fp8(c1_[0], c1_[1], c1_[2], c1_[3]); *(u32x2*)(h1q + off + bj * 128) = q8; }
                    ss += (v0[0] * v0[0] + v0[1] * v0[1]) + (v0[2] * v0[2] + v0[3] * v0[3]) + (v1[0] * v1[0] + v1[1] * v1[1]) + (v1[2] * v1[2] + v1[3] * v1[3]); }
                ss += __shfl_xor(ss, 16); ss += __shfl_xor(ss, 32);
                if (fq == 0) ss1[row * 16 + u.pn * 4 + wc] = ss;
                if (m == 3) asm volatile("" ::: "memory"); }
    }
};
struct EpiSoftmax {
    int ldc; const float* ss1; float qscale;
    __device__ __forceinline__ void operator()(AccT& acc, const Unit& u, int wr, int wc, int fr, int fq, LAS unsigned char* ldsx, int, int) const {
        LAS float* XM = (LAS float*)ldsx;
        LAS float* XS = (LAS float*)(ldsx + 4096);
#pragma unroll
        for (int ai = 0; ai < 2; ++ai)
#pragma unroll
            for (int m = 0; m < 4; ++m) { float mx = -INFINITY;
                { const f32x4* sp = (const f32x4*)(ss1 + ((size_t)u.pm * 256 + EROW(ai, m)) * 16); const f32x4 s0 = sp[0], s1 = sp[1], s2 = sp[2], s3 = sp[3];
                  const float tot = ((s0[0] + s0[1]) + (s0[2] + s0[3])) + ((s1[0] + s1[1]) + (s1[2] + s1[3])) + ((s2[0] + s2[1]) + (s2[2] + s2[3])) + ((s3[0] + s3[1]) + (s3[2] + s3[3]));
                  const float sc = qscale / sqrtf(tot * (1.0f / D) + RMS_EPS);
#pragma unroll
                  for (int bj = 0; bj < 2; ++bj)
#pragma unroll
                      for (int n = 0; n < 2; ++n) acc[ai][bj][m][n] = acc[ai][bj][m][n] * sc; }
#pragma unroll
                for (int bj = 0; bj < 2; ++bj)
#pragma unroll
                    for (int n = 0; n < 2; ++n) { const f32x4 v = acc[ai][bj][m][n]; mx = fmaxf(mx, fmaxf(fmaxf(v[0], v[1]), fmaxf(v[2], v[3]))); }
                mx = fmaxf(mx, __shfl_xor(mx, 16)); mx = fmaxf(mx, __shfl_xor(mx, 32));
                if (fq == 0) XM[EROW(ai, m) * 4 + wc] = mx; }
        LDS_WAIT(); __builtin_amdgcn_s_barrier(); asm volatile("" ::: "memory");
#pragma unroll
        for (int ai = 0; ai < 2; ++ai)
#pragma unroll
            for (int m = 0; m < 4; ++m) { const f32x4 mv = *(const LAS f32x4*)(XM + EROW(ai, m) * 4); const float mx = fmaxf(fmaxf(mv[0], mv[1]), fmaxf(mv[2], mv[3])); float s = 0.f;
#pragma unroll
                for (int bj = 0; bj < 2; ++bj)
#pragma unroll
                    for (int n = 0; n < 2; ++n) { f32x4 v = acc[ai][bj][m][n];
                        v[0] = __builtin_amdgcn_exp2f(v[0] - mx); v[1] = __builtin_amdgcn_exp2f(v[1] - mx); v[2] = __builtin_amdgcn_exp2f(v[2] - mx); v[3] = __builtin_amdgcn_exp2f(v[3] - mx);
                        acc[ai][bj][m][n] = v; s += (v[0] + v[1]) + (v[2] + v[3]); }
                s += __shfl_xor(s, 16); s += __shfl_xor(s, 32);
                if (fq == 0) XS[EROW(ai, m) * 4 + wc] = s; }
        LDS_WAIT(); __builtin_amdgcn_s_barrier(); asm volatile("" ::: "memory");
        unsigned char* base = (unsigned char*)u.o;
#pragma unroll
        for (int ai = 0; ai < 2; ++ai)
#pragma unroll
            for (int m = 0; m < 4; ++m) { const f32x4 sv = *(const LAS f32x4*)(XS + EROW(ai, m) * 4); const float inv = P8_SCALE / ((sv[0] + sv[1]) + (sv[2] + sv[3]));
                unsigned char* rowp = base + (size_t)EROW(ai, m) * ldc + ECOL(0);
#pragma unroll
                for (int bj = 0; bj < 2; ++bj) { const f32x4 v0 = acc[ai][bj][m][0] * inv, v1 = acc[ai][bj][m][1] * inv;
                    u32x2 q8; q8.x = pk4_fp8(v0[0], v0[1], v0[2], v0[3]); q8.y = pk4_fp8(v1[0], v1[1], v1[2], v1[3]); *(u32x2*)(rowp + bj * 128) = q8; } }
    }
};
struct EpiWo {
    const bf16_t* hb; bf16_t* ho; unsigned char* h2q;
    __device__ __forceinline__ void operator()(const AccT& acc, const Unit& u, int wr, int wc, int fr, int fq, LAS unsigned char*, int, int) const {
        const size_t r0 = (size_t)u.pm * 256; const int c0 = u.pn * 256 + ECOL(0);
#pragma unroll
        for (int ai = 0; ai < 2; ++ai)
#pragma unroll
            for (int m = 0; m < 4; ++m) { const size_t off = (r0 + EROW(ai, m)) * D + c0;
#pragma unroll
                for (int bj = 0; bj < 2; ++bj) { const u32x4 hw = *(const u32x4*)(hb + off + bj * 128);
                    f32x4 v0 = acc[ai][bj][m][0] * P8_INV, v1 = acc[ai][bj][m][1] * P8_INV;
                    v0[0] += bflo(hw.x); v0[1] += bfhi(hw.x); v0[2] += bflo(hw.y); v0[3] += bfhi(hw.y); v1[0] += bflo(hw.z); v1[1] += bfhi(hw.z); v1[2] += bflo(hw.w); v1[3] += bfhi(hw.w);
                    *(u32x4*)(ho + off + bj * 128) = pack8(v0, v1); } }
    }
};
struct EpiGateUp {
    const float* sw6; const float* bgu_all; unsigned char* act;
    static __device__ __forceinline__ float swiglu_c(float g, float l1) {
        const float t = fminf(g, 7.0f * GLU_C), xl1 = __builtin_amdgcn_fmed3f(l1, -6.0f, 8.0f);
        return xl1 * (t * __builtin_amdgcn_rcpf(1.0f + __builtin_amdgcn_exp2f(-t)));
    }
    __device__ __forceinline__ void operator()(const AccT& acc, const Unit& u, int wr, int wc, int fr, int fq, LAS unsigned char*, int, int) const {
        const int cc = u.pn * 128 + wc * 32 + 8 * fq; const float* bgu = bgu_all + (size_t)u.ex * 2 * DFF; const size_t slot0 = (size_t)u.pm * 256;
        const float kl = sw6[u.ex], kg = kl * GLU_C;
        const f32x4 bg0 = *(const f32x4*)(bgu + cc) * GLU_C, bg1 = *(const f32x4*)(bgu + cc + 4) * GLU_C, bl0 = *(const f32x4*)(bgu + DFF + cc) + 1.0f, bl1 = *(const f32x4*)(bgu + DFF + cc + 4) + 1.0f;
#pragma unroll
        for (int ai = 0; ai < 2; ++ai)
#pragma unroll
            for (int m = 0; m < 4; ++m) { const int r = EROW(ai, m);
                const f32x4 g0 = acc[ai][0][m][0] * kg + bg0, g1 = acc[ai][0][m][1] * kg + bg1, l0 = acc[ai][1][m][0] * kl + bl0, l1 = acc[ai][1][m][1] * kl + bl1;
                f32x4 a0, a1;
#pragma unroll
                for (int j = 0; j < 4; ++j) { a0[j] = swiglu_c(g0[j], l0[j]); a1[j] = swiglu_c(g1[j], l1[j]); }
                u32x2 q8; q8.x = pk4_fp8(a0[0], a0[1], a0[2], a0[3]); q8.y = pk4_fp8(a1[0], a1[1], a1[2], a1[3]); *(u32x2*)(act + (slot0 + r) * DFF + cc) = q8; }
    }
};
struct EpiDown {
    const float* gate_slot; const float* bd_all; unsigned char* Y;
    __device__ __forceinline__ void operator()(const AccT& acc, const Unit& u, int wr, int wc, int fr, int fq, LAS unsigned char*, int, int) const {
        const int c0 = u.pn * 256 + ECOL(0); const float* bd = bd_all + (size_t)u.ex * D; const size_t slot0 = (size_t)u.pm * 256;
        f32x4 bv[2][2];
#pragma unroll
        for (int bj = 0; bj < 2; ++bj) { bv[bj][0] = *(const f32x4*)(bd + c0 + bj * 128); bv[bj][1] = *(const f32x4*)(bd + c0 + bj * 128 + 4); }
#pragma unroll
        for (int ai = 0; ai < 2; ++ai)
#pragma unroll
            for (int m = 0; m < 4; ++m) { const int r = EROW(ai, m); const float g = gate_slot[slot0 + r] * Y8_SCALE; unsigned char* rowp = Y + (slot0 + r) * D + c0;
#pragma unroll
                for (int bj = 0; bj < 2; ++bj) { f32x4 v0 = (acc[ai][bj][m][0] * W8_INV + bv[bj][0]) * g, v1 = (acc[ai][bj][m][1] * W8_INV + bv[bj][1]) * g;
#pragma unroll
                    for (int q = 0; q < 4; ++q) { v0[q] = __builtin_amdgcn_fmed3f(v0[q], -440.f, 440.f); v1[q] = __builtin_amdgcn_fmed3f(v1[q], -440.f, 440.f); }
                    u32x2 q8; q8.x = pk4_fp8(v0[0], v0[1], v0[2], v0[3]); q8.y = pk4_fp8(v1[0], v1[1], v1[2], v1[3]); *(u32x2*)(rowp + bj * 128) = q8; } }
    }
};

struct SchedDense {
    int nM, nN, G, c; char* O; unsigned lda2, ldb2; size_t ldo2;
    __device__ __forceinline__ bool next(int i, Unit& u) const {
        int pm, pn; if (!pg8::static_order(i, G, c, nM, nN, pm, pn)) return false;
        u.pm = pm; u.pn = pn; u.ex = 0; u.a = (unsigned)pm * 256u * lda2; u.b = (unsigned)pn * 256u * ldb2; u.o = O ? O + (size_t)pm * 256 * ldo2 + (size_t)pn * 512 : nullptr; return true;
    }
};
struct SchedScores {
    int G, c; char* P;
    __device__ __forceinline__ bool next(int i, Unit& u) const {
        int pm, pn; if (!pg8::static_order(i, G, c, MTOK / 256, NHEAD, pm, pn)) return false;
        u.pm = pm; u.pn = pn; u.ex = 0; const int b = pm / (SEQ / 256);
        u.a = (unsigned)pm * 256u * D; u.b = (unsigned)(b * NHEAD + pn) * 256u * D; u.o = P + ((size_t)pm * 256 * D + pn * HDIM); return true;
    }
};
struct SchedAttnOut {
    int G, c;
    __device__ __forceinline__ bool next(int i, Unit& u) const {
        int pm, pn; if (!pg8::static_order(i, G, c, MTOK / 256, D / 256, pm, pn)) return false;
        u.pm = pm; u.pn = pn; u.ex = 0; const int b = pm / (SEQ / 256);
        u.a = (unsigned)pm * 256u * D; u.b = (unsigned)(b * D + pn * 256) * (unsigned)D; u.o = nullptr; return true;
    }
};
struct SchedList {
    int first, n; unsigned a0, bstep; char* O;
    __device__ __forceinline__ bool next(int i, Unit& u) const {
        if (i >= n) return false; u.pm = 0; u.pn = first + i; u.ex = 0; u.a = a0; u.b = (unsigned)(first + i) * bstep; u.o = O; return true;
    }
};

struct SchedMoe {
    int T, nN, G, c; unsigned bexp; const LAS unsigned char* tile_e; unsigned astep, ldb;
    __device__ __forceinline__ bool next(int i, Unit& u) const {
        int pm, pn; if (!pg8::static_order(i, G, c, T, nN, pm, pn)) return false;
        const int e = __builtin_amdgcn_readfirstlane((int)tile_e[pm]);
        u.pm = pm; u.pn = pn; u.ex = e; u.a = (unsigned)pm * astep; u.b = (unsigned)e * bexp + (unsigned)pn * 256u * ldb; u.o = nullptr; return true;
    }
};
#define XB_TMO      128
#define XB_XCNT(j)  (256  + 64 * (j))
#define XB_XSUB(j)  (1280 + 64 * (j))
#define XB_XGEN(j)  (2304 + 64 * (j))
#define XB_TOP      3328
#define XB_TOPGEN   3392
#define XCD_BAR_WORDS 3456
#define XB_SPIN_CAP (1u << 20)
__device__ __forceinline__ unsigned xb_ld(unsigned* p)              { return __hip_atomic_load(p, __ATOMIC_RELAXED, __HIP_MEMORY_SCOPE_AGENT); }
__device__ __forceinline__ unsigned xb_add(unsigned* p, unsigned v) { return __hip_atomic_fetch_add(p, v, __ATOMIC_RELAXED, __HIP_MEMORY_SCOPE_AGENT); }
__device__ __forceinline__ unsigned xb_xcc_id() { return (unsigned)__builtin_amdgcn_s_getreg((3 << 11) | 20) & 0xFu; }
#define XB_SPIN(cond, bar) do { unsigned _sp = 0; while (cond) { __builtin_amdgcn_s_sleep(1); \
    if ((++_sp & 255u) == 0u) { if (xb_ld(&(bar)[XB_TMO])) break; if (_sp > XB_SPIN_CAP) { atomicAdd(&(bar)[XB_TMO], 1u); break; } } } } while (0)
struct XcdBarrier { unsigned* bar; unsigned x; volatile LAS unsigned* st; };
__device__ __forceinline__ XcdBarrier xcd_barrier_post(unsigned* bar, volatile LAS unsigned* st) {
    XcdBarrier b; b.bar = bar; b.x = xb_xcc_id(); b.st = st;
    if (threadIdx.x == 0) (void)xb_add(&bar[XB_XCNT(b.x)], 1u);
    return b;
}
__device__ __forceinline__ void xcd_barrier_complete(unsigned* bar, unsigned x, unsigned& nloc, unsigned& nx) {
    const unsigned G = gridDim.x * gridDim.y * gridDim.z;
    unsigned sum, cnt, mine, sp = 0u;
    for (;;) {
        sum = 0u; cnt = 0u; mine = 0u;
#pragma unroll
        for (unsigned j = 0; j < 16; ++j) { const unsigned c = xb_ld(&bar[XB_XCNT(j)]); sum += c; cnt += (c > 0u) ? 1u : 0u; mine = (j == x) ? c : mine; }
        if (sum == G) break;
        __builtin_amdgcn_s_sleep(1);
        if ((++sp & 255u) == 0u) { if (xb_ld(&bar[XB_TMO])) break; if (sp > XB_SPIN_CAP) { atomicAdd(&bar[XB_TMO], 1u); break; } }
    }
    nloc = mine > 0u ? mine : 1u; nx = cnt > 0u ? cnt : 1u;
}
__device__ __forceinline__ void xcd_barrier(const XcdBarrier& b) {
    asm volatile("s_waitcnt vmcnt(0)" ::: "memory");
    __syncthreads();
    if (threadIdx.x == 0) {
        unsigned* bar = b.bar;
        __builtin_amdgcn_s_waitcnt(0);
        unsigned nloc = b.st[0], nx = b.st[1];
        if (nloc == 0u) { xcd_barrier_complete(bar, b.x, nloc, nx); b.st[0] = nloc; b.st[1] = nx; }
        const unsigned old = xb_add(&bar[XB_XSUB(b.x)], 1u);
        const unsigned gen = old / nloc;
        if (old + 1u == (gen + 1u) * nloc) {
            __builtin_amdgcn_fence(__ATOMIC_RELEASE, "agent");
            asm volatile("s_waitcnt vmcnt(0)" ::: "memory");
            const unsigned og = xb_add(&bar[XB_TOP], 1u);
            const unsigned tg = og / nx;
            if (og + 1u == (tg + 1u) * nx) xb_add(&bar[XB_TOPGEN], 1u);
            else XB_SPIN(xb_ld(&bar[XB_TOPGEN]) == tg, bar);
            __builtin_amdgcn_fence(__ATOMIC_ACQUIRE, "agent");
            xb_add(&bar[XB_XGEN(b.x)], 1u);
            asm volatile("s_waitcnt vmcnt(0)" ::: "memory");
        } else {
            XB_SPIN(xb_ld(&bar[XB_XGEN(b.x)]) == gen, bar);
            __builtin_amdgcn_fence(__ATOMIC_ACQUIRE, "agent");
            asm volatile("s_waitcnt vmcnt(0)" ::: "memory");
        }
    }
    __syncthreads();
}
__device__ __forceinline__ void wg_self_sync() {
    asm volatile("s_waitcnt vmcnt(0)" ::: "memory");
    __syncthreads();
    if (threadIdx.x == 0) { __builtin_amdgcn_fence(__ATOMIC_ACQUIRE, "agent"); asm volatile("s_waitcnt vmcnt(0)" ::: "memory"); }
    __syncthreads();
}

struct Args {
    const float *x, *mem, *g_mix, *w_in, *w_pool, *pool_scale, *conv_w, *w_out, *g_xattn, *g_mem, *w_q, *w_k, *w_v, *w_o, *g_moe, *w_router, *b_router, *w_gate_up, *b_gate_up, *w_down, *b_down, *g_final;
    float* out; unsigned char* ws; int ph_lo, ph_hi, rep_phase, pad_;
};

__device__ __forceinline__ void transpose_item(const float* W, int ldw, int K, bf16_t* WT, int k0, int srccol0, int n0, const float* g, LAS float* scr, int lane) {
#pragma unroll 8
    for (int i = 0; i < 32; ++i) { const int kk = 2 * i + (lane >> 5); scr[kk * 33 + (lane & 31)] = W[(size_t)(k0 + kk) * ldw + srccol0 + (lane & 31)]; }
    LDS_WAIT(); asm volatile("" ::: "memory");
    const int c = lane & 7;
    float gs[8];
#pragma unroll
    for (int q = 0; q < 8; ++q) gs[q] = g ? g[k0 + 8 * c + q] : 1.0f;
#pragma unroll
    for (int j = 0; j < 4; ++j) { const int n = (lane >> 3) + 8 * j; const LAS float* s = scr + (8 * c) * 33 + n;
        u32x4 o; o.x = cvt_pk_bf16(s[0 * 33] * gs[0], s[1 * 33] * gs[1]); o.y = cvt_pk_bf16(s[2 * 33] * gs[2], s[3 * 33] * gs[3]); o.z = cvt_pk_bf16(s[4 * 33] * gs[4], s[5 * 33] * gs[5]); o.w = cvt_pk_bf16(s[6 * 33] * gs[6], s[7 * 33] * gs[7]);
        *(u32x4*)(WT + (size_t)(n0 + n) * K + k0 + 8 * c) = o; }
    LDS_WAIT(); asm volatile("" ::: "memory");
}
__device__ __forceinline__ void transpose_item_f8(const float* W, int ldw, int K, unsigned char* WT, int k0, int srccol0, int n0, const float* g, float scale, LAS float* scr, int lane) {
#pragma unroll 8
    for (int i = 0; i < 32; ++i) { const int kk = 2 * i + (lane >> 5); scr[kk * 33 + (lane & 31)] = W[(size_t)(k0 + kk) * ldw + srccol0 + (lane & 31)]; }
    LDS_WAIT(); asm volatile("" ::: "memory");
    const int c = lane & 7;
    float gs[8];
#pragma unroll
    for (int q = 0; q < 8; ++q) gs[q] = (g ? g[k0 + 8 * c + q] : 1.0f) * scale;
#pragma unroll
    for (int j = 0; j < 4; ++j) { const int n = (lane >> 3) + 8 * j; const LAS float* s = scr + (8 * c) * 33 + n;
        u32x2 o; o.x = pk4_fp8(s[0 * 33] * gs[0], s[1 * 33] * gs[1], s[2 * 33] * gs[2], s[3 * 33] * gs[3]); o.y = pk4_fp8(s[4 * 33] * gs[4], s[5 * 33] * gs[5], s[6 * 33] * gs[6], s[7 * 33] * gs[7]);
        *(u32x2*)(WT + (size_t)(n0 + n) * K + k0 + 8 * c) = o; }
    LDS_WAIT(); asm volatile("" ::: "memory");
}
__device__ __forceinline__ void rms_row_to_bf16(const float* xrow, const float* g, bf16_t* orow, int lane) {
    const f32x4* xr = (const f32x4*)xrow + lane; const f32x4* gr = (const f32x4*)g + lane;
    f32x4 v[4]; float s = 0.f;
#pragma unroll
    for (int j = 0; j < 4; ++j) { v[j] = xr[64 * j]; s += (v[j][0] * v[j][0] + v[j][1] * v[j][1]) + (v[j][2] * v[j][2] + v[j][3] * v[j][3]); }
    const float rstd = 1.0f / sqrtf(wave_sum(s) * (1.0f / D) + RMS_EPS);
    u32x2* o8 = (u32x2*)orow + lane;
#pragma unroll
    for (int j = 0; j < 4; ++j) { const f32x4 gv = gr[64 * j]; u32x2 w; w.x = cvt_pk_bf16(v[j][0] * rstd * gv[0], v[j][1] * rstd * gv[1]); w.y = cvt_pk_bf16(v[j][2] * rstd * gv[2], v[j][3] * rstd * gv[3]); o8[64 * j] = w; }
}
constexpr int CVT_PITCH = 144;
__device__ __forceinline__ void flush_rows128(LAS unsigned char* scr, unsigned char* dst0, size_t row_stride, int lane) {
    LDS_WAIT(); asm volatile("" ::: "memory");
#pragma unroll
    for (int j = 0; j < 8; ++j) { const int r = 8 * j + (lane >> 3), ch = lane & 7; const u32x4 v = *(const LAS u32x4*)(scr + r * CVT_PITCH + ch * 16); *(u32x4*)(dst0 + (size_t)r * row_stride + ch * 16) = v; }
    LDS_WAIT(); asm volatile("" ::: "memory");
}
template <bool F8>
__device__ __forceinline__ void cvt_block(const float* W, int ldw, int K, void* WT, int k0, int srccol0, int n0, const float* g, float scale, int lane, LAS unsigned char* scr) {
    const float* src = W + (size_t)k0 * ldw + srccol0 + lane;
    float v[64];
#pragma unroll
    for (int q = 0; q < 64; ++q) v[q] = src[(size_t)q * ldw];
#pragma unroll
    for (int q = 0; q < 64; ++q) v[q] *= (g ? g[k0 + q] : 1.0f) * scale;
    if constexpr (F8) { u32x4* dst = (u32x4*)((unsigned char*)WT + (size_t)(n0 + lane) * K + k0);
#pragma unroll
        for (int c = 0; c < 4; ++c) { u32x4 o; o.x = pk4_fp8(v[16 * c], v[16 * c + 1], v[16 * c + 2], v[16 * c + 3]); o.y = pk4_fp8(v[16 * c + 4], v[16 * c + 5], v[16 * c + 6], v[16 * c + 7]);
            o.z = pk4_fp8(v[16 * c + 8], v[16 * c + 9], v[16 * c + 10], v[16 * c + 11]); o.w = pk4_fp8(v[16 * c + 12], v[16 * c + 13], v[16 * c + 14], v[16 * c + 15]); dst[c] = o; }
    } else {
#pragma unroll
        for (int c = 0; c < 8; ++c) { u32x4 o; o.x = cvt_pk_bf16(v[8 * c], v[8 * c + 1]); o.y = cvt_pk_bf16(v[8 * c + 2], v[8 * c + 3]); o.z = cvt_pk_bf16(v[8 * c + 4], v[8 * c + 5]); o.w = cvt_pk_bf16(v[8 * c + 6], v[8 * c + 7]);
            *(LAS u32x4*)(scr + lane * CVT_PITCH + c * 16) = o; }
        flush_rows128(scr, (unsigned char*)((bf16_t*)WT + (size_t)n0 * K + k0), (size_t)K * 2, lane);
    }
}
__device__ __forceinline__ u32x6 fp6_pack32(const f32x16& a, const f32x16& b) { return __builtin_amdgcn_cvt_scalef32_2xpk16_fp6_f32(a, b, 1.0f); }
constexpr int CVT6_PITCH = 112;
__device__ __forceinline__ void flush_rows96(LAS unsigned char* scr, unsigned char* dst0, size_t row_stride, int lane) {
    LDS_WAIT(); asm volatile("" ::: "memory");
#pragma unroll
    for (int j = 0; j < 6; ++j) { const int c = j * 64 + lane, r = c / 6, ch = c - 6 * r; const u32x4 v = *(const LAS u32x4*)(scr + r * CVT6_PITCH + ch * 16); *(u32x4*)(dst0 + (size_t)r * row_stride + ch * 16) = v; }
    LDS_WAIT(); asm volatile("" ::: "memory");
}
struct CvtItem { const float* src; unsigned char* dst; const float* g; int ldw; float scale; };
__device__ __forceinline__ void cvt_load64(float (&v)[64], const CvtItem& it) {
#pragma unroll
    for (int q = 0; q < 64; ++q) v[q] = it.src[(size_t)q * it.ldw];
}
__device__ __forceinline__ void cvt_pack64_f8(const float (&v)[64], const CvtItem& it, LAS unsigned char* p) {
#pragma unroll
    for (int c = 0; c < 4; ++c) { float w[16];
#pragma unroll
        for (int q = 0; q < 16; ++q) w[q] = v[16 * c + q] * ((it.g ? it.g[16 * c + q] : 1.0f) * it.scale);
        u32x4 o; o.x = pk4_fp8(w[0], w[1], w[2], w[3]); o.y = pk4_fp8(w[4], w[5], w[6], w[7]); o.z = pk4_fp8(w[8], w[9], w[10], w[11]); o.w = pk4_fp8(w[12], w[13], w[14], w[15]);
        *(LAS u32x4*)(p + c * 16) = o; }
}
__device__ __forceinline__ void cvt_pack64_f6(const float (&v)[64], const CvtItem& it, LAS unsigned char* p) {
#pragma unroll
    for (int c = 0; c < 2; ++c) { f32x16 a, b;
#pragma unroll
        for (int q = 0; q < 16; ++q) { a[q] = __builtin_amdgcn_fmed3f(v[32 * c + q] * (it.g[32 * c + q] * it.scale), -7.5f, 7.5f); b[q] = __builtin_amdgcn_fmed3f(v[32 * c + 16 + q] * (it.g[32 * c + 16 + q] * it.scale), -7.5f, 7.5f); }
        const u32x6 o = fp6_pack32(a, b);
        *(LAS u32x2*)(p + 24 * c) = (u32x2){o[0], o[1]}; *(LAS u32x2*)(p + 24 * c + 8) = (u32x2){o[2], o[3]}; *(LAS u32x2*)(p + 24 * c + 16) = (u32x2){o[4], o[5]}; }
}
template <bool RAW>
__device__ __forceinline__ void rms_rows4_to_bf16(const float* x0, const float* g, bf16_t* o0, float* rstd_out, int lane) {
    f32x4 v[4][4]; float ssq[4];
#pragma unroll
    for (int r = 0; r < 4; ++r)
#pragma unroll
        for (int j = 0; j < 4; ++j) v[r][j] = ((const f32x4*)(x0 + (size_t)r * D))[lane + 64 * j];
#pragma unroll
    for (int r = 0; r < 4; ++r) { float s = 0.f;
#pragma unroll
        for (int j = 0; j < 4; ++j) s += (v[r][j][0] * v[r][j][0] + v[r][j][1] * v[r][j][1]) + (v[r][j][2] * v[r][j][2] + v[r][j][3] * v[r][j][3]);
        ssq[r] = 1.0f / sqrtf(wave_sum(s) * (1.0f / D) + RMS_EPS); }
#pragma unroll
    for (int j = 0; j < 4; ++j) { const f32x4 gv = ((const f32x4*)g)[lane + 64 * j];
#pragma unroll
        for (int r = 0; r < 4; ++r) { const float rs = RAW ? 1.0f : ssq[r]; u32x2 w; w.x = cvt_pk_bf16(v[r][j][0] * rs * (RAW ? 1.0f : gv[0]), v[r][j][1] * rs * (RAW ? 1.0f : gv[1])); w.y = cvt_pk_bf16(v[r][j][2] * rs * (RAW ? 1.0f : gv[2]), v[r][j][3] * rs * (RAW ? 1.0f : gv[3]));
            ((u32x2*)(o0 + (size_t)r * D))[lane + 64 * j] = w; } }
    if constexpr (RAW) { if (lane < 4) rstd_out[lane] = ssq[lane]; }
}
__device__ __forceinline__ void p0_prologue(const Args& A, LAS unsigned char* lds, int cu, int G, int wave, int lane_in) {
    int lane = lane_in;
    LAS unsigned char* scr = lds + wave * 16384;
    const int gw = cu * NWAVES + wave, NGW = G * NWAVES;
    unsigned char* ws = A.ws;
    constexpr int B_GU = (D / 64) * (2 * DFF / 64), B_DN = (DFF / 64) * (D / 64);
    constexpr int NSI_GU = NEXP * B_GU / 2, NSI_DN = NEXP * B_DN / 2;
#define GU_ITEM(sit_, hb_, dst_) do { const int e = (sit_) / (B_GU / 2), r = (sit_) % (B_GU / 2), kb = 2 * (r % 8) + (hb_), nb = r / 8, rho0 = 64 * nb, pn = rho0 >> 8, bj = (rho0 >> 7) & 1, cc = rho0 & 127; \
        (dst_).src = A.w_gate_up + (size_t)e * D * 2 * DFF + (size_t)(64 * kb) * (2 * DFF) + bj * DFF + 128 * pn + cc + lane; (dst_).ldw = 2 * DFF; (dst_).g = A.g_moe + 64 * kb; \
        (dst_).dst = ws + WS_WGU + ((size_t)e * 2 * DFF + rho0) * K6B + (r % 8) * 96; } while (0)
    { float va[64], vb[64]; CvtItem ia, ib; const int per = (NSI_GU + NGW - 1) / NGW; int sit = gw * per; const int send = (sit + per < NSI_GU) ? sit + per : NSI_GU;
      if (sit < send) { int e_cur = -1; float s_e = 0.f;
          GU_ITEM(sit, 0, ia); GU_ITEM(sit, 1, ib); cvt_load64(va, ia); cvt_load64(vb, ib);
          while (true) { const int e = sit / (B_GU / 2);
              if (e != e_cur) { e_cur = e; const float* w_e = A.w_gate_up + (size_t)e * D * 2 * DFF + lane; float ss = 0.f;
#pragma unroll
                  for (int q = 0; q < 16; ++q) { const float t = w_e[(size_t)q * (2 * DFF)] * A.g_moe[q]; ss += t * t; }
                  ss = wave_sum(ss); s_e = W6_TARGET / sqrtf(ss * (1.0f / 1024.0f) + 1e-30f);
                  if (lane == 0) ((float*)(ws + WS_SW6))[e] = 1.0f / (H6_SCALE * s_e); }
              ia.scale = s_e; ib.scale = s_e;
              unsigned char* const dst = ia.dst; const int nx = sit + 1; const bool more = nx < send;
              cvt_pack64_f6(va, ia, scr + lane * CVT6_PITCH);
              if (more) { GU_ITEM(nx, 0, ia); cvt_load64(va, ia); }
              cvt_pack64_f6(vb, ib, scr + lane * CVT6_PITCH + 48);
              flush_rows96(scr, dst, (size_t)K6B, lane);
              if (!more) break;
              GU_ITEM(nx, 1, ib); cvt_load64(vb, ib); sit = nx; } } }
#undef GU_ITEM
    asm volatile("" : "+v"(lane));
#define EXPERT_ITEM(it_, dst_) do { const int i2 = (it_), e = i2 / B_DN, r = i2 % B_DN, kb = r % 16, nb = r / 16; \
        (dst_).src = A.w_down + (size_t)e * DFF * D + (size_t)(64 * kb) * D + 64 * nb + lane; (dst_).ldw = D; (dst_).g = nullptr; (dst_).scale = W8_SCALE / GLU_C; \
        (dst_).dst = ws + WS_WD + (size_t)e * D * DFF + (size_t)(64 * nb) * DFF + 64 * kb; } while (0)
    { float va[64], vb[64]; CvtItem ia, ib; int sit = gw;
      if (sit < NSI_DN) { EXPERT_ITEM(2 * sit, ia); EXPERT_ITEM(2 * sit + 1, ib); cvt_load64(va, ia); cvt_load64(vb, ib);
          while (true) { unsigned char* const dst = ia.dst; const int nx = sit + NGW; const bool more = nx < NSI_DN;
              cvt_pack64_f8(va, ia, scr + lane * CVT_PITCH);
              if (more) { EXPERT_ITEM(2 * nx, ia); cvt_load64(va, ia); }
              cvt_pack64_f8(vb, ib, scr + lane * CVT_PITCH + 64);
              flush_rows128(scr, dst, (size_t)D, lane);
              if (!more) break;
              EXPERT_ITEM(2 * nx + 1, ib); cvt_load64(vb, ib); sit = nx; } } }
#undef EXPERT_ITEM
    asm volatile("" : "+v"(lane));
    constexpr int B_IN = (D / 64) * (INW / 64), B_SQ = (D / 64) * (D / 64);
    for (int it = gw; it < B_IN + 5 * B_SQ; it += NGW) {
        int r = it;
        if (r < B_IN) { const int rho0 = 64 * (r % 32); int src = rho0;
            if (rho0 >= 1024) { const int q = rho0 - 1024; src = 1024 + ((q >> 7) & 1) * CONVW + 128 * (q >> 8) + (q & 127); }
            cvt_block<false>(A.w_in, INW, D, ws + WS_WIN, 64 * (r / 32), src, rho0, A.g_mix, 1.0f, lane, scr); continue; } r -= B_IN;
        const int which = r / B_SQ; r %= B_SQ; const int k0 = 64 * (r / 16), n0 = 64 * (r % 16);
        if (which == 0) cvt_block<false>(A.w_out, D, D, (k0 < POOLW) ? ws + WS_WOUT : ws + WS_WC, k0, n0, n0, nullptr, 1.0f, lane, scr);
        else if (which == 1) { }
        else if (which == 2) cvt_block<false>(A.w_k, D, D, ws + WS_WK, k0, n0, n0, nullptr, 1.0f, lane, scr);
        else if (which == 3) cvt_block<false>(A.w_v, D, D, ws + WS_WV, k0, n0, n0, nullptr, 1.0f, lane, scr);
        else cvt_block<false>(A.w_o, D, D, ws + WS_WO, k0, n0, n0, nullptr, 1.0f, lane, scr);
    }
    { const int gt = gw * 64 + lane, NT = NGW * 64; bf16_t* wpb = (bf16_t*)(ws + WS_WPB);
      for (int i = gt; i < 2 * 256 * 256; i += NT) { const int pn = i >> 16, kl = (i >> 8) & 255, jl = i & 255; float v = 0.f;
          if ((kl >> 7) == (jl >> 7)) v = A.w_pool[((size_t)(2 * pn + (kl >> 7)) * 128 + (kl & 127)) * 128 + (jl & 127)] * A.pool_scale[256 * pn + jl];
          wpb[i] = (bf16_t)(cvt_pk_bf16(v, 0.f) & 0xffffu); }
      { u32x2* wq = (u32x2*)(ws + WS_WQ);
        for (int i = gt; i < D * D / 4; i += NT) { const f32x4 w = ((const f32x4*)A.w_q)[i]; const float g = A.g_xattn[i >> 8]; u32x2 o; o.x = cvt_pk_bf16(w[0] * g, w[1] * g); o.y = cvt_pk_bf16(w[2] * g, w[3] * g); wq[i] = o; } }
      bf16_t* wrt = (bf16_t*)(ws + WS_WRT);
      for (int i = gt; i < NEXP * D; i += NT) { const int e = i >> 10, k = i & 1023; const float w = A.g_moe[k] * A.w_router[(size_t)k * NEXP + e];
          const unsigned hi = cvt_pk_bf16(w, 0.f) & 0xffffu; const float r = w - __uint_as_float(hi << 16);
          wrt[i] = (bf16_t)hi; wrt[NEXP * D + i] = (bf16_t)(cvt_pk_bf16(r, 0.f) & 0xffffu); } }
    for (int m = gw * 4; m < MTOK; m += NGW * 4) rms_rows4_to_bf16<true>(A.x + (size_t)m * D, A.g_mix, (bf16_t*)(ws + WS_XN) + (size_t)m * D, (float*)(ws + WS_RSTD0) + m, lane);
    for (int m = gw * 4; m < MROWS; m += NGW * 4) rms_rows4_to_bf16<false>(A.mem + (size_t)m * D, A.g_mem, (bf16_t*)(ws + WS_MN) + (size_t)m * D, nullptr, lane);
}

__device__ __forceinline__ void p10_quant6(const Args& A, int cu, int G, int wave, int lane) {
    const bf16_t* h2 = (const bf16_t*)(A.ws + WS_H1B); const float* rstd2 = (const float*)(A.ws + WS_RSTD2); unsigned char* q6 = A.ws + WS_H2B;
    const int gw = cu * NWAVES + wave, NGW = G * NWAVES, hf = lane >> 5, l = lane & 31;
#pragma unroll 2
    for (int r0 = gw * 2; r0 < MTOK; r0 += NGW * 2) { const int r = r0 + hf;
        const u32x4* src = (const u32x4*)(h2 + (size_t)r * D + l * 32); const u32x4 x0 = src[0], x1 = src[1], x2 = src[2], x3 = src[3];
        const float sc = rstd2[r] * H6_SCALE; f32x16 a, b;
#pragma unroll
        for (int q = 0; q < 4; ++q) { a[2 * q] = bflo(x0[q]); a[2 * q + 1] = bfhi(x0[q]); a[8 + 2 * q] = bflo(x1[q]); a[8 + 2 * q + 1] = bfhi(x1[q]); b[2 * q] = bflo(x2[q]); b[2 * q + 1] = bfhi(x2[q]); b[8 + 2 * q] = bflo(x3[q]); b[8 + 2 * q + 1] = bfhi(x3[q]); }
#pragma unroll
        for (int q = 0; q < 16; ++q) { a[q] = __builtin_amdgcn_fmed3f(a[q] * sc, -7.5f, 7.5f); b[q] = __builtin_amdgcn_fmed3f(b[q] * sc, -7.5f, 7.5f); }
        const u32x6 o = fp6_pack32(a, b); u32x2* dst = (u32x2*)(q6 + (size_t)r * K6B + l * 24);
        dst[0] = (u32x2){o[0], o[1]}; dst[1] = (u32x2){o[2], o[3]}; dst[2] = (u32x2){o[4], o[5]}; }
}

__device__ __forceinline__ void ld8(const bf16_t* p, float (&f)[8]) { const u32x4 w = *(const u32x4*)p; f[0] = bflo(w.x); f[1] = bfhi(w.x); f[2] = bflo(w.y); f[3] = bfhi(w.y); f[4] = bflo(w.z); f[5] = bfhi(w.z); f[6] = bflo(w.w); f[7] = bfhi(w.w); }
__device__ __forceinline__ void st8(bf16_t* p, const float (&f)[8]) { u32x4 w; w.x = cvt_pk_bf16(f[0], f[1]); w.y = cvt_pk_bf16(f[2], f[3]); w.z = cvt_pk_bf16(f[4], f[5]); w.w = cvt_pk_bf16(f[6], f[7]); *(u32x4*)p = w; }
__device__ __forceinline__ void p2_mixers(const Args& A, int cu, int G, int wave, int lane) {
    const bf16_t* proj = (const bf16_t*)(A.ws + WS_PROJ); bf16_t* mixa = (bf16_t*)(A.ws + WS_MIXA);
    unsigned* ctr = (unsigned*)(A.ws + WS_CTL) + 1024;
    for (;;) { unsigned run_ = 0u; if (lane == 0) run_ = __hip_atomic_fetch_add(ctr, 1u, __ATOMIC_RELAXED, __HIP_MEMORY_SCOPE_AGENT); const int run = __builtin_amdgcn_readfirstlane((int)run_); if (run >= MTOK / 32) break;
        const int row0 = run * 32, t0 = row0 % SEQ;
        { const int c0 = 8 * lane, w = 2 << (lane >> 4); const bf16_t* up = proj + (size_t)row0 * PROJW + c0;
          float sum[8];
#pragma unroll
          for (int q = 0; q < 8; ++q) sum[q] = 0.f;
          if (t0 > 0) { for (int j = 1; j < w; ++j) { float f[8]; ld8(up - (size_t)j * PROJW, f);
#pragma unroll
                  for (int q = 0; q < 8; ++q) sum[q] += f[q]; } }
#pragma unroll 8
          for (int i = 0; i < 32; ++i) { const int t = t0 + i; float cur[8], d[8]; ld8(up + (size_t)i * PROJW, cur);
              const float inv = 1.0f / (float)((t + 1 < w) ? (t + 1) : w);
#pragma unroll
              for (int q = 0; q < 8; ++q) { sum[q] += cur[q]; d[q] = sum[q] * inv - cur[q]; }
              st8(mixa + (size_t)(row0 + i) * D + c0, d);
              if (t - w + 1 >= 0) { float old[8]; ld8(up + (ptrdiff_t)(i - w + 1) * PROJW, old);
#pragma unroll
                  for (int q = 0; q < 8; ++q) sum[q] -= old[q]; } } }
        { const int c0 = 8 * lane; const bf16_t* gbp = proj + (size_t)row0 * PROJW + POOLW + c0; const bf16_t* zp = gbp + CONVW;
          float w0[8], w1[8], w2[8], z2[8], z1[8];
#pragma unroll
          for (int q = 0; q < 8; ++q) { w0[q] = A.conv_w[c0 + q]; w1[q] = A.conv_w[CONVW + c0 + q]; w2[q] = A.conv_w[2 * CONVW + c0 + q]; z2[q] = 0.f; z1[q] = 0.f; }
          if (t0 > 0) { ld8(zp - (size_t)2 * PROJW, z2); ld8(zp - (size_t)PROJW, z1); }
#pragma unroll 8
          for (int i = 0; i < 32; ++i) { float z0[8], g[8], y[8]; ld8(zp + (size_t)i * PROJW, z0); ld8(gbp + (size_t)i * PROJW, g);
#pragma unroll
              for (int q = 0; q < 8; ++q) { y[q] = g[q] * (w0[q] * z2[q] + w1[q] * z1[q] + w2[q] * z0[q]); z2[q] = z1[q]; z1[q] = z0[q]; }
              st8(mixa + (size_t)(row0 + i) * D + POOLW + c0, y); } }
    }
}

constexpr int WR_PITCH = 1032;
__device__ __forceinline__ void p9_router(const Args& A, LAS unsigned char* lds, int cu, int wave, int lane) {
    const bf16_t* h2 = (const bf16_t*)(A.ws + WS_H1B); const bf16_t* wrt = (const bf16_t*)(A.ws + WS_WRT);
    float* rstd2 = (float*)(A.ws + WS_RSTD2); int* etok = (int*)(A.ws + WS_ETOK); float* gtok = (float*)(A.ws + WS_GTOK); int* cnt = (int*)(A.ws + WS_CNT);
    LAS int* lcnt = (LAS int*)(lds + MISC_OFF + 256);
    LAS bf16_t* WL = (LAS bf16_t*)lds;
    if (threadIdx.x < NEXP) lcnt[threadIdx.x] = 0;
    for (int i = threadIdx.x; i < 2 * NEXP * (D / 8); i += NTHREADS) { const int row = i >> 7, ch = i & 127; *(LAS u32x4*)(WL + row * WR_PITCH + ch * 8) = *(const u32x4*)(wrt + (size_t)row * D + ch * 8); }
    __syncthreads();
    const int t = lane & 31, h = lane >> 5; const int tok = cu * 256 + wave * 32 + t;
    const bf16_t* xp = h2 + (size_t)tok * D + 16 * h;
    const LAS bf16_t* wh = WL + t * WR_PITCH + 16 * h; const LAS bf16_t* wl = wh + NEXP * WR_PITCH;
    f32x16 acc;
#pragma unroll
    for (int r = 0; r < 16; ++r) acc[r] = 0.f;
    float ss = 0.f;
#pragma unroll 4
    for (int s = 0; s < 32; ++s) {
        const u32x4 x0 = *(const u32x4*)(xp + 32 * s), x1 = *(const u32x4*)(xp + 32 * s + 8);
#pragma unroll
        for (int q = 0; q < 4; ++q) { const float a = bflo(x0[q]), b = bfhi(x0[q]), c = bflo(x1[q]), d = bfhi(x1[q]); ss += (a * a + b * b) + (c * c + d * d); }
        const bf16x8 b0 = __builtin_bit_cast(bf16x8, x0), b1 = __builtin_bit_cast(bf16x8, x1);
        const bf16x8 ah0 = *(const LAS bf16x8*)(wh + 32 * s), ah1 = *(const LAS bf16x8*)(wh + 32 * s + 8), al0 = *(const LAS bf16x8*)(wl + 32 * s), al1 = *(const LAS bf16x8*)(wl + 32 * s + 8);
        acc = __builtin_amdgcn_mfma_f32_32x32x16_bf16(ah0, b0, acc, 0, 0, 0); acc = __builtin_amdgcn_mfma_f32_32x32x16_bf16(al0, b0, acc, 0, 0, 0);
        acc = __builtin_amdgcn_mfma_f32_32x32x16_bf16(ah1, b1, acc, 0, 0, 0); acc = __builtin_amdgcn_mfma_f32_32x32x16_bf16(al1, b1, acc, 0, 0, 0);
    }
    ss += __shfl_xor(ss, 32);
    const float rs = 1.0f / sqrtf(ss * (1.0f / D) + RMS_EPS);
    float lgA[16], lgB[16];
#pragma unroll
    for (int r = 0; r < 16; ++r) { const float mine = acc[r], other = __shfl_xor(mine, 32); lgA[r] = h ? other : mine; lgB[r] = h ? mine : other; }
#pragma unroll
    for (int e = 0; e < 32; ++e) { const int r = (e & 3) + 4 * (e >> 3); const float b = A.b_router[e]; if ((e >> 2) & 1) lgB[r] = lgB[r] * rs + b; else lgA[r] = lgA[r] * rs + b; }
    float tv[4]; int ti[4];
#pragma unroll
    for (int k = 0; k < 4; ++k) { float best = -INFINITY; int bi = 0;
#pragma unroll
        for (int e = 0; e < 32; ++e) { const int r = (e & 3) + 4 * (e >> 3); const float v = ((e >> 2) & 1) ? lgB[r] : lgA[r]; if (v > best) { best = v; bi = e; } }
        tv[k] = best; ti[k] = bi;
#pragma unroll
        for (int e = 0; e < 32; ++e) { const int r = (e & 3) + 4 * (e >> 3); if (bi == e) { if ((e >> 2) & 1) lgB[r] = -INFINITY; else lgA[r] = -INFINITY; } } }
    const float e1 = __expf(tv[1] - tv[0]), e2 = __expf(tv[2] - tv[0]), e3 = __expf(tv[3] - tv[0]); const float inv = 1.0f / (1.0f + e1 + e2 + e3);
    if (h == 0) { rstd2[tok] = rs;
        *(int4*)(etok + (size_t)tok * 4) = make_int4(ti[0], ti[1], ti[2], ti[3]);
        *(f32x4*)(gtok + (size_t)tok * 4) = (f32x4){inv, e1 * inv, e2 * inv, e3 * inv};
        atomicAdd((int*)&lcnt[ti[0]], 1); atomicAdd((int*)&lcnt[ti[1]], 1); atomicAdd((int*)&lcnt[ti[2]], 1); atomicAdd((int*)&lcnt[ti[3]], 1); }
    __syncthreads();
    if (threadIdx.x < NEXP) cnt[cu * NEXP + threadIdx.x] = lcnt[threadIdx.x];
}

__device__ __forceinline__ void p10_scatter(const Args& A, LAS unsigned char* lds, int cu, int G) {
    const int* cnt = (const int*)(A.ws + WS_CNT); const int* etok = (const int*)(A.ws + WS_ETOK); const float* gtok = (const float*)(A.ws + WS_GTOK);
    int* slot_of_tok = (int*)(A.ws + WS_SLOT_OF_TOK); int* tok_of_slot = (int*)(A.ws + WS_TOK_OF_SLOT); float* gate_of_slot = (float*)(A.ws + WS_GATE_OF_SLOT); int* pstart = (int*)(A.ws + WS_PSTART);
    float* rs_slot = (float*)(A.ws + WS_RS_SLOT); const float* rstd2 = (const float*)(A.ws + WS_RSTD2);
    LAS int* sll = (LAS int*)lds;
    LAS int* ptot = (LAS int*)(lds + MISC_OFF + 512);
    LAS int* pbef = ptot + 512;
    LAS int* base = pbef + 512;
    LAS int* lcnt = base + 32;
    LAS int* pst = lcnt + 32;
    LAS int* tot = pst + 40;
    const int t = threadIdx.x;
    { const int e = t & 31, part = t >> 5; int a = 0, b = 0;
      for (int c2 = part * 16; c2 < part * 16 + 16; ++c2) { if (c2 < G) { const int v = cnt[c2 * NEXP + e]; a += v; if (c2 < cu) b += v; } }
      ptot[part * 32 + e] = a; pbef[part * 32 + e] = b; }
    if (t < NEXP) lcnt[t] = 0;
    __syncthreads();
    if (t < NEXP) { int a = 0, b = 0; for (int p = 0; p < 16; ++p) { a += ptot[p * 32 + t]; b += pbef[p * 32 + t]; } tot[t] = a; base[t] = b; }
    __syncthreads();
    if (t == 0) { int s = 0; for (int e = 0; e < NEXP; ++e) { pst[e] = s; s += ((tot[e] + 255) >> 8) << 8; } pst[NEXP] = s; }
    __syncthreads();
    if (t < 256) { const int tok = cu * 256 + t; const int4 ev = *(const int4*)(etok + (size_t)tok * 4); const f32x4 gv = *(const f32x4*)(gtok + (size_t)tok * 4);
        const int es[4] = {ev.x, ev.y, ev.z, ev.w}; int sl[4];
        const float rs = rstd2[tok];
#pragma unroll
        for (int k = 0; k < 4; ++k) { const int e = es[k]; const int rank = atomicAdd((int*)&lcnt[e], 1); const int slot = pst[e] + base[e] + rank; sl[k] = slot; tok_of_slot[slot] = tok; gate_of_slot[slot] = gv[k]; rs_slot[slot] = rs; sll[t * 4 + k] = slot; }
        *(int4*)(slot_of_tok + (size_t)tok * 4) = make_int4(sl[0], sl[1], sl[2], sl[3]); }
    if (cu < NEXP) { const int e = cu; for (int s = pst[e] + tot[e] + t; s < pst[e + 1]; s += NTHREADS) { tok_of_slot[s] = 0; gate_of_slot[s] = 0.f; rs_slot[s] = 0.f; } }
    if (cu == 0 && t <= NEXP) pstart[t] = pst[t];
}

__device__ __forceinline__ void p12_final(const Args& A, float* dst, int cu, int wave, int lane) {
    const int* slot_of_tok = (const int*)(A.ws + WS_SLOT_OF_TOK); const unsigned char* Y = A.ws + WS_Y; const bf16_t* h2 = (const bf16_t*)(A.ws + WS_H1B);
    f32x4 gf[4];
#pragma unroll
    for (int j = 0; j < 4; ++j) gf[j] = ((const f32x4*)(A.g_final + lane * 16))[j];
    int4 sln[4];
#pragma unroll
    for (int r = 0; r < 4; ++r) sln[r] = *(const int4*)(slot_of_tok + (size_t)(cu * 256 + wave * 32 + r) * 4);
    for (int i = 0; i < 32; i += 4) { const int tok0 = cu * 256 + wave * 32 + i;
        u32x4 hv[4][2], yv[4][4]; int4 slc[4];
#pragma unroll
        for (int r = 0; r < 4; ++r) { slc[r] = sln[r]; if (i + 4 < 32) sln[r] = *(const int4*)(slot_of_tok + (size_t)(tok0 + 4 + r) * 4); }
#pragma unroll
        for (int r = 0; r < 4; ++r) { const int4 sl = slc[r]; const int sls[4] = {sl.x, sl.y, sl.z, sl.w};
            hv[r][0] = *(const u32x4*)(h2 + (size_t)(tok0 + r) * D + lane * 16); hv[r][1] = *(const u32x4*)(h2 + (size_t)(tok0 + r) * D + lane * 16 + 8);
#pragma unroll
            for (int k = 0; k < 4; ++k) yv[r][k] = *(const u32x4*)(Y + (size_t)sls[k] * D + lane * 16); }
#pragma unroll
        for (int r = 0; r < 4; ++r) { float v[16];
#pragma unroll
            for (int q = 0; q < 4; ++q) { v[2 * q] = bflo(hv[r][0][q]); v[2 * q + 1] = bfhi(hv[r][0][q]); v[8 + 2 * q] = bflo(hv[r][1][q]); v[8 + 2 * q + 1] = bfhi(hv[r][1][q]); }
            float ysum[16];
#pragma unroll
            for (int q = 0; q < 16; ++q) ysum[q] = 0.f;
#pragma unroll
            for (int k = 0; k < 4; ++k)
#pragma unroll
                for (int q = 0; q < 4; ++q) { const f32x2 lo = __builtin_amdgcn_cvt_pk_f32_fp8((int)yv[r][k][q], false), hi = __builtin_amdgcn_cvt_pk_f32_fp8((int)yv[r][k][q], true);
                    ysum[4 * q] += lo[0]; ysum[4 * q + 1] += lo[1]; ysum[4 * q + 2] += hi[0]; ysum[4 * q + 3] += hi[1]; }
            float s = 0.f;
#pragma unroll
            for (int q = 0; q < 16; ++q) { v[q] += ysum[q] * Y8_INV; s += v[q] * v[q]; }
            const float rs = 1.0f / sqrtf(wave_sum(s) * (1.0f / D) + RMS_EPS);
#pragma unroll
            for (int j = 0; j < 4; ++j) ((f32x4*)(dst + (size_t)(tok0 + r) * D + lane * 16))[j] = (f32x4){v[4 * j] * rs * gf[j][0], v[4 * j + 1] * rs * gf[j][1], v[4 * j + 2] * rs * gf[j][2], v[4 * j + 3] * rs * gf[j][3]}; } }
}

constexpr int N_PHASES = 14;
__device__ __forceinline__ Args load_args() {
    union { Args a; unsigned long long w[sizeof(Args) / 8]; } u;
#if defined(__HIP_DEVICE_COMPILE__)
    typedef __attribute__((address_space(4))) const unsigned long long cu64;
    const cu64* q = (const cu64*)__builtin_amdgcn_kernarg_segment_ptr(); asm volatile("" : "+s"(q));
#pragma unroll
    for (int i = 0; i < (int)(sizeof(Args) / 8); ++i) u.w[i] = q[i];
#endif
    return u.a;
}
__global__ void __launch_bounds__(NTHREADS, 2) mk_fwd(Args args_in) {
    extern __shared__ __attribute__((aligned(16))) unsigned char lds_raw[];
    LAS unsigned char* lds = (LAS unsigned char*)lds_raw;
    const int tid0 = threadIdx.x;
    const int G = gridDim.x, cu = blockIdx.x;
    unsigned char* ws = args_in.ws;
    for (int u = tid0; u < (LDS_BYTES - MISC_OFF) / 4; u += NTHREADS) ((LAS unsigned*)(lds + MISC_OFF))[u] = 0u;
    __syncthreads();
    XcdBarrier bar; bar.bar = (unsigned*)(ws + WS_CTL) + 4096; bar.x = 0; bar.st = nullptr;
    const bool one_launch = (args_in.ph_hi - args_in.ph_lo) > 1;
    if (one_launch) bar = xcd_barrier_post((unsigned*)(ws + WS_CTL) + 4096, (volatile LAS unsigned*)(lds + MISC_OFF + 32));
#define lo (load_args().ph_lo)
#define hi (load_args().ph_hi)
#define rep_phase (load_args().rep_phase)
#ifdef ONLY_PHASE
#define IN(k) ((k) == ONLY_PHASE && lo <= (k) && (k) < hi)
#else
#define IN(k) (lo <= (k) && (k) < hi)
#endif
#define SEAM(k) do { if (IN(k) && IN((k) + 1)) xcd_barrier(bar); } while (0)
#define SEAM_LOCAL(k) do { if (IN(k) && IN((k) + 1)) wg_self_sync(); } while (0)
    const float QSCALE = 0.0625f * 1.4426950408889634f;

    if (IN(0)) for (int rep_ = 0; rep_ < ((rep_phase == 0) ? 2 : 1); ++rep_) { const Args args = load_args(); p0_prologue(args, lds, cu, G, __builtin_amdgcn_readfirstlane(tid0 >> 6), tid0 & 63); }
    SEAM(0);
    int tid_l = tid0; asm volatile("" : "+v"(tid_l));
    const int tid = tid_l, lane = tid & 63, wave = __builtin_amdgcn_readfirstlane(tid >> 6);
    if (IN(1)) for (int rep_ = 0; rep_ < ((rep_phase == 1) ? 2 : 1); ++rep_) { const Args args = load_args();
        SchedDense S{MTOK / 256, INW / 256, G, cu, nullptr, D * 2, D * 2, 0};
        EpiProj E{(bf16_t*)(ws + WS_PROJ), (const float*)(ws + WS_RSTD0)};
        pg8::gemm_phase<EpiProj, SchedDense, false, true, true>(lds, ws + WS_XN, ws + WS_WIN, D * 2, D * 2, D * 2, nullptr, S, E);
    }
    SEAM(1);
    if (IN(2)) for (int rep_ = 0; rep_ < ((rep_phase == 2) ? 2 : 1); ++rep_) { const Args args = load_args();
        for (int q = cu; q < (MROWS / 256) * 8; q += G) { const int pm = q >> 3, pn = q & 7;
            SchedList S{pn, 1, (unsigned)pm * 256u * D * 2u, 256u * D * 2u, (char*)(ws + WS_KV) + ((size_t)pm * 256 * 2 * D + pn * 256) * 2};
            EpiStore E{2 * D}; pg8::gemm_phase<EpiStore, SchedList, false, false, true>(lds, ws + WS_MN, ws + WS_WK, D * 2, D * 2, D * 2, nullptr, S, E); }
        for (int q = cu; q < 8; q += G) { const int pmn = q >> 1, pn = q & 1;
            SchedList S{0, 1, ((unsigned)pmn * 256u * D + (unsigned)pn * 256u) * 2u, 0u, (char*)(ws + WS_WC) + ((size_t)pmn * 256 * D + pn * 256) * 2};
            EpiStore E{D}; pg8::gemm_phase<EpiStore, SchedList, false, false, true>(lds, ws + WS_WOUT, ws + WS_WPB + (size_t)pn * 256 * 256 * 2, 256 * 2, D * 2, 256 * 2, nullptr, S, E); }
        p2_mixers(args, cu, G, wave, lane);
    }
    SEAM(2);
    if (IN(4)) for (int rep_ = 0; rep_ < ((rep_phase == 4) ? 2 : 1); ++rep_) { const Args args = load_args();
        for (int q = cu; q < BATCH * NHEAD * 4; q += G) { const int bh = q >> 2, qt = q & 3, b = bh >> 2, h = bh & 3;
            {
              SchedList S{0, 1, ((unsigned)b * 256u * 2u * D + (unsigned)h * HDIM) * 2u, 0u, (char*)(ws + WS_MT) + ((size_t)bh * 256 * D + qt * 256)};
              EpiStore8 E{D}; pg8::gemm_phase<EpiStore8, SchedList, false, false, true>(lds, ws + WS_KV, ws + WS_WQ + ((size_t)qt * 256 * D + h * HDIM) * 2, HDIM * 2, 2 * D * 2, D * 2, nullptr, S, E); }
            {
              SchedList S{0, 1, ((unsigned)qt * 256u * D + (unsigned)h * HDIM) * 2u, 0u, (char*)(ws + WS_NT) + (((size_t)b * D + qt * 256) * D + h * HDIM)};
              EpiStore8 E{D}; pg8::gemm_phase<EpiStore8, SchedList, false, false, true>(lds, ws + WS_WO, ws + WS_KV + ((size_t)b * 256 * 2 * D + D + h * HDIM) * 2, HDIM * 2, D * 2, 2 * D * 2, nullptr, S, E); } }
        SchedDense S{MTOK / 256, D / 256, G, cu, nullptr, D * 2, D * 2, 0};
        EpiOutProj E{(const bf16_t*)(ws + WS_XN), (bf16_t*)(ws + WS_H1B), (float*)(ws + WS_SS1), ws + WS_H1Q};
        pg8::gemm_phase<EpiOutProj, SchedDense, false, true, true>(lds, ws + WS_MIXA, ws + WS_WC, D * 2, D * 2, D * 2, nullptr, S, E);
    }
    SEAM(4);
    if (IN(5)) for (int rep_ = 0; rep_ < ((rep_phase == 5) ? 2 : 1); ++rep_) { const Args args = load_args();
        SchedScores S{G, cu, (char*)(ws + WS_P)};
        EpiSoftmax E{D, (const float*)(ws + WS_SS1), QSCALE};
        pg8::gemm_phase<EpiSoftmax, SchedScores, false, true, true, true>(lds, ws + WS_H1Q, ws + WS_MT, D, D, D, nullptr, S, E);
    }
    SEAM(5);
    if (IN(8)) for (int rep_ = 0; rep_ < ((rep_phase == 8) ? 2 : 1); ++rep_) { const Args args = load_args();
        SchedAttnOut S{G, cu};
        const bool dummy_ = (rep_phase == 8) && (rep_ == 0);
        EpiWo E{(const bf16_t*)(ws + WS_H1B), dummy_ ? (bf16_t*)(ws + WS_DP) : (bf16_t*)(ws + WS_H1B), dummy_ ? ws + WS_XN : ws + WS_H2B};
        pg8::gemm_phase<EpiWo, SchedAttnOut, false, true, true, true>(lds, ws + WS_P, ws + WS_NT, D, D, D, nullptr, S, E);
    }
    SEAM(8);
    if (IN(9)) for (int rep_ = 0; rep_ < ((rep_phase == 9) ? 2 : 1); ++rep_) { const Args args = load_args(); p9_router(args, lds, cu, wave, lane); }
    SEAM(9);
    if (IN(10)) for (int rep_ = 0; rep_ < ((rep_phase == 10) ? 2 : 1); ++rep_) { const Args args = load_args(); p10_scatter(args, lds, cu, G); p10_quant6(args, cu, G, wave, lane); }
    SEAM(10);
    if (IN(11) || IN(12)) {
        LAS int* pst = (LAS int*)(lds + MISC_OFF + 1024);
        LAS unsigned char* tile_e = (LAS unsigned char*)(lds + MISC_OFF + 2048);
        const int* pstart = (const int*)(ws + WS_PSTART);
        if (tid <= NEXP) pst[tid] = pstart[tid];
        __syncthreads();
        const int T = pst[NEXP] >> 8;
        for (int tt = tid; tt < T; tt += NTHREADS) { int e = 0; for (int k = 1; k < NEXP; ++k) if (pst[k] <= (tt << 8)) e = k; tile_e[tt] = (unsigned char)e; }
        __syncthreads();
        if (IN(11)) for (int rep_ = 0; rep_ < ((rep_phase == 11) ? 2 : 1); ++rep_) { const Args args = load_args();
            SchedMoe S{T, 8, G, cu, 2u * DFF * K6B, tile_e, 0u, (unsigned)K6B};
            EpiGateUp E{(const float*)(ws + WS_SW6), args.b_gate_up, ws + WS_ACT};
            pg8::gemm_phase<EpiGateUp, SchedMoe, true, true, true, false, true>(lds, ws + WS_H2B, ws + WS_WGU, K6B, K6B, K6B, (const int*)(ws + WS_TOK_OF_SLOT), S, E);
        }
        SEAM(11);
        if (IN(12)) for (int rep_ = 0; rep_ < ((rep_phase == 12) ? 2 : 1); ++rep_) { const Args args = load_args();
            SchedMoe S{T, 4, G, cu, (unsigned)D * DFF, tile_e, 256u * DFF, (unsigned)DFF};
            EpiDown E{(const float*)(ws + WS_GATE_OF_SLOT), args.b_down, ws + WS_Y};
            pg8::gemm_phase<EpiDown, SchedMoe, false, true, true, true>(lds, ws + WS_ACT, ws + WS_WD, DFF, DFF, DFF, nullptr, S, E);
        }
    }
    SEAM(12);
    if (IN(13)) for (int rep_ = 0; rep_ < ((rep_phase == 13) ? 2 : 1); ++rep_) { const Args args = load_args(); p12_final(args, args.out, cu, wave, lane); }
#undef IN
#undef SEAM
#undef SEAM_LOCAL
#undef lo
#undef hi
#undef rep_phase
}

extern "C" void kernel_launch(void* const* d_in, const int* in_sizes, int n_in, void* d_out, int out_size, void* d_ws, size_t ws_size, hipStream_t stream) {
    static int grid = 0;
    if (grid == 0) {
        if (n_in != 22 || in_sizes[0] != MTOK * D || out_size != MTOK * D || ws_size < WS_END) { fprintf(stderr, "kernel_launch: unexpected shapes (n_in %d, in0 %d, out %d, ws %zu)\n", n_in, n_in > 0 ? in_sizes[0] : -1, out_size, ws_size); grid = -1; return; }
        int dev = 0, cus = 0, per_cu = 0;
        if (hipGetDevice(&dev) != hipSuccess || hipDeviceGetAttribute(&cus, hipDeviceAttributeMultiprocessorCount, dev) != hipSuccess) { grid = -1; return; }
        if (hipFuncSetAttribute((const void*)mk_fwd, hipFuncAttributeMaxDynamicSharedMemorySize, LDS_BYTES) != hipSuccess) { fprintf(stderr, "kernel_launch: hipFuncSetAttribute failed\n"); grid = -1; return; }
        if (hipOccupancyMaxActiveBlocksPerMultiprocessor(&per_cu, (const void*)mk_fwd, NTHREADS, LDS_BYTES) != hipSuccess || per_cu < 1) { fprintf(stderr, "kernel_launch: occupancy query says %d blocks per CU\n", per_cu); (void)hipGetLastError(); grid = -1; return; }
        grid = cus;
        if (grid != 256) fprintf(stderr, "kernel_launch: note: %d CUs\n", grid);
    }
    if (grid < 0) return;
    (void)hipMemsetAsync((char*)d_ws + WS_CTL, 0, CTL_ZERO_BYTES, stream);
    Args a{};
    const float** ap = (const float**)&a;
    for (int i = 0; i < 22; ++i) ap[i] = (const float*)d_in[i];
    a.out = (float*)d_out; a.ws = (unsigned char*)d_ws;
#ifdef PROBE_PHASE
    a.rep_phase = PROBE_PHASE;
#else
    a.rep_phase = -1;
#endif
#if MK_N_LAUNCHES == 1
    a.ph_lo = 0; a.ph_hi = N_PHASES;
    hipLaunchKernelGGL(mk_fwd, dim3(grid), dim3(NTHREADS), LDS_BYTES, stream, a);
#else
    for (int p = 0; p < N_PHASES; ++p) { a.ph_lo = p; a.ph_hi = p + 1; hipLaunchKernelGGL(mk_fwd, dim3(grid), dim3(NTHREADS), LDS_BYTES, stream, a); }
#endif
}
```

```cpp
#include <hip/hip_runtime.h>
#include <cstdio>
#include <cstdint>

#ifndef MK_N_LAUNCHES
#define MK_N_LAUNCHES 1
#endif

#define LAS __attribute__((address_space(3)))
#define GAS __attribute__((address_space(1)))
typedef unsigned short bf16_t;
typedef short bf16x8 __attribute__((ext_vector_type(8)));
typedef float f32x4 __attribute__((ext_vector_type(4)));
typedef float f32x2 __attribute__((ext_vector_type(2)));
typedef unsigned u32x4 __attribute__((ext_vector_type(4)));
typedef unsigned u32x2 __attribute__((ext_vector_type(2)));

constexpr int D = 1024, BATCH = 16, SEQ = 4096, MTOK = BATCH * SEQ, MEMLEN = 256, MROWS = BATCH * MEMLEN;
constexpr int NHEAD = 4, HDIM = 256, NEXP = 32, TOPK = 4, DFF = 1024, INW = 2048, POOLW = 512, CONVW = 512;
constexpr int PROJW = POOLW + 2 * CONVW;
constexpr float RMS_EPS = 1e-5f;
constexpr int NWAVES = 8, NTHREADS = 512;
constexpr float GLU_C = 1.702f * 1.4426950408889634f;
constexpr float W8_SCALE = 32.0f, W8_INV = 1.0f / 32.0f;
constexpr int MAXSLOTS = MTOK * TOPK + NEXP * 256;

constexpr size_t MiB = 1u << 20;
constexpr size_t WS_CTL = 0, CTL_ZERO_BYTES = 64 * 1024;
constexpr size_t WS_SS1 = 1 * MiB;
constexpr size_t WS_RSTD2 = 5 * MiB;
constexpr size_t WS_RSTD0 = 5 * MiB + 512 * 1024;
constexpr size_t WS_ETOK = 6 * MiB;
constexpr size_t WS_GTOK = 7 * MiB;
constexpr size_t WS_SLOT_OF_TOK = 8 * MiB;
constexpr size_t WS_TOK_OF_SLOT = 9 * MiB;
constexpr size_t WS_GATE_OF_SLOT = 11 * MiB;
constexpr size_t WS_CNT = 13 * MiB;
constexpr size_t WS_PSTART = 13 * MiB + 64 * 1024;
constexpr size_t WS_WRT = 13 * MiB + 512 * 1024;
constexpr size_t WS_WPB = 14 * MiB;
constexpr size_t WS_RS_SLOT = 14 * MiB + 512 * 1024;
constexpr size_t WS_WD = 16 * MiB;
constexpr size_t WS_WGU = 48 * MiB;
constexpr size_t WS_H2B = 112 * MiB;
constexpr size_t WS_Y = 176 * MiB;
constexpr size_t WS_ACT = 440 * MiB;
constexpr size_t WS_H1B = 704 * MiB;
constexpr size_t WS_XN = 176 * MiB;
constexpr size_t WS_PROJ = 304 * MiB;
constexpr size_t WS_H1Q = 560 * MiB;
constexpr size_t WS_MIXA = 832 * MiB;
constexpr size_t WS_MT = 624 * MiB;
constexpr size_t WS_NT = 640 * MiB;
constexpr size_t WS_P = 432 * MiB;
constexpr size_t WS_MN = 960 * MiB;
constexpr size_t WS_KV = 968 * MiB;
constexpr size_t WS_WIN = 984 * MiB;
constexpr size_t WS_WOUT = 988 * MiB;
constexpr size_t WS_WQ = 990 * MiB, WS_WK = 992 * MiB, WS_WV = 994 * MiB, WS_WO = 996 * MiB;
constexpr size_t WS_WC = 998 * MiB;
constexpr size_t WS_END = 1000 * MiB;
static_assert(WS_Y + (size_t)MAXSLOTS * 1024 <= WS_ACT && WS_ACT + (size_t)MAXSLOTS * 1024 <= WS_H1B && WS_H1B + 128 * MiB <= WS_MIXA && WS_RS_SLOT + (size_t)MAXSLOTS * 4 <= WS_WD, "d_ws map");
constexpr float P8_SCALE = 256.0f, P8_INV = 1.0f / 256.0f;
constexpr float Y8_SCALE = 4.0f, Y8_INV = 0.25f;

constexpr int RING_BYTES = 131072;
constexpr int XCH_OFF = RING_BYTES;
constexpr int MISC_OFF = RING_BYTES + 8192;
constexpr int LDS_BYTES = 147456;

__device__ __forceinline__ unsigned cvt_pk_bf16(float lo, float hi) { unsigned r; asm volatile("v_cvt_pk_bf16_f32 %0, %1, %2" : "=v"(r) : "v"(lo), "v"(hi)); return r; }
__device__ __forceinline__ unsigned pk4_fp8(float a, float b, float c, float d) { int w = 0; w = __builtin_amdgcn_cvt_pk_fp8_f32(a, b, w, false); w = __builtin_amdgcn_cvt_pk_fp8_f32(c, d, w, true); return (unsigned)w; }
__device__ __forceinline__ float bf2f(unsigned short v) { return __uint_as_float(((unsigned)v) << 16); }
__device__ __forceinline__ float bflo(unsigned w) { return __uint_as_float(w << 16); }
__device__ __forceinline__ float bfhi(unsigned w) { return __uint_as_float(w & 0xffff0000u); }
__device__ __forceinline__ float wave_sum(float v) {
#pragma unroll
    for (int o = 1; o < 64; o <<= 1) v += __shfl_xor(v, o);
    return v;
}
#define LDS_WAIT() asm volatile("s_waitcnt lgkmcnt(0)" ::: "memory")
#define VM_WAIT() asm volatile("s_waitcnt vmcnt(0)" ::: "memory")

namespace pg8 {
constexpr int BM = 256, BK = 64, HALF = 128, HTB = HALF * BK * 2, STAGE_BYTES = 8 * HTB, NXCD = 8, WGM = 8;
__host__ __device__ __forceinline__ int lds_byte(int r, int c) { const int st = (r >> 4) * 2 + (c >> 5), rr = r & 15, cc = c & 31, ob = rr * 64 + cc * 2; return st * 1024 + (ob ^ (((ob >> 9) & 1) << 5)); }
__host__ __device__ __forceinline__ void stage_rc(int b, int& R, int& C) { const int st = b / 1024, sb = b % 1024, swz = sb ^ (((sb >> 9) & 1) << 5); R = (st >> 1) * 16 + swz / 64; C = (st & 1) * 32 + (swz % 64) / 2; }
__host__ __device__ __forceinline__ int perm32(int rho) { const int n = rho >> 4, i = rho & 15; return 8 * (i >> 2) + 4 * n + (i & 3); }

struct Unit { unsigned a, b; char* o; int pm, pn, ex; };

__device__ __forceinline__ bool static_order(int i, int G, int c, int nM, int nN, int& pm, int& pn) {
    const int nwg = nM * nN; const long L = (long)i * G + c; if (L >= nwg) return false;
    int wgid = (int)L; { const int q = nwg / NXCD, r = nwg % NXCD, xcd = wgid % NXCD, off = wgid / NXCD; wgid = (xcd < r ? xcd * (q + 1) : r * (q + 1) + (xcd - r) * q) + off; }
    const int nig = WGM * nN, gid = wgid / nig, fm = gid * WGM, gsz = (nM - fm) < WGM ? (nM - fm) : WGM;
    pm = fm + ((wgid % nig) % gsz); pn = (wgid % nig) / gsz; return true;
}

__device__ __forceinline__ bool plain_order(int i, int Gx, int r, int nM, int nN, int& pm, int& pn) {
    const int w = i * Gx + r; if (w >= nM * nN) return false;
    const int nig = WGM * nN, gid = w / nig, fm = gid * WGM, gsz = (nM - fm) < WGM ? (nM - fm) : WGM;
    pm = fm + ((w % nig) % gsz); pn = (w % nig) / gsz; return true;
}
typedef int v4i_t __attribute__((ext_vector_type(4)));
typedef int v8i_t __attribute__((ext_vector_type(8)));
typedef unsigned long long u64x2_t __attribute__((ext_vector_type(2)));
template <class Epi, class Sched, bool GATHER, bool ALIGN_EPI, bool SP2, bool F8 = false, bool WIDE = false>
__device__ __forceinline__ void gemm_phase(LAS unsigned char* lds, const void* Abase, const void* Bbase, const int KB, const int lda2, const int ldb2, const int* gidx, const Sched& S, const Epi& E) {
    int tid_ = threadIdx.x; asm volatile("" : "+v"(tid_));
    const int tid = tid_, wid = __builtin_amdgcn_readfirstlane(tid >> 6), lane = tid & 63, wr = wid >> 2, wc = wid & 3, fr = lane & 15, fq = lane >> 4;
    const int nt = KB / (BK * 2);
    unsigned voffA, voffB, vG[4], vN[4], vS[4]; int gR = 0; unsigned gC = 0u;
    { int R, C; stage_rc(tid * 16, R, C); const int Rb = WIDE ? 64 * (R >> 5) + perm32(R & 31) : (R & ~31) + perm32(R & 31); voffB = (unsigned)(Rb * ldb2 + C * 2); voffA = (unsigned)(R * lda2 + C * 2); gR = R; gC = (unsigned)(C * 2); }
#define PG8_LOADROWS_RAW(v, pm_) do { _Pragma("unroll") for (int _p = 0; _p < 4; ++_p) v[_p] = (unsigned)gidx[(pm_) * 256 + gR + 64 * _p]; } while (0)
#define PG8_ROWOFF(raw) ((raw) * (unsigned)lda2 + gC)
    const unsigned pstepA = GATHER ? 0u : 64u * (unsigned)lda2, pstepB = (WIDE ? 128u : 64u) * (unsigned)ldb2;
    const unsigned kstep = (unsigned)(BK * 2);
    const unsigned hstepA = GATHER ? 0u : (unsigned)HALF * lda2, hstepB = (WIDE ? 32u : (unsigned)HALF) * ldb2;
    const __amdgpu_buffer_rsrc_t rsA = __builtin_amdgcn_make_buffer_rsrc((void*)Abase, 0, -1, 0x00020000), rsB = __builtin_amdgcn_make_buffer_rsrc((void*)Bbase, 0, -1, 0x00020000);
    const unsigned ldsw = (unsigned)wid * 1024u;
    const int aoff = lds_byte(wr * 64 + fr, fq * 8), boff = lds_byte(wc * 32 + fr, fq * 8);
    constexpr int KOFF = 1024;
#define PG8_SA(b, h) (((b) * 2 + (h)) * HTB)
#define PG8_SB(b, h) ((4 + (b) * 2 + (h)) * HTB)
#define PG8_STAGE_B(bufoff, soff) do { _Pragma("unroll") for (int _i = 0; _i < 2; ++_i) \
        __builtin_amdgcn_raw_ptr_buffer_load_lds(rsB, (LAS void*)(lds + (bufoff) + ldsw + _i * 8192), 16, voffB, (soff) + _i * pstepB, 0, 0); } while (0)
#define PG8_STAGE_A(bufoff, soff, h) do { _Pragma("unroll") for (int _i = 0; _i < 2; ++_i) \
        __builtin_amdgcn_raw_ptr_buffer_load_lds(rsA, (LAS void*)(lds + (bufoff) + ldsw + _i * 8192), 16, GATHER ? vG[2 * (h) + _i] : voffA, (soff) + (h) * hstepA + _i * pstepA, 0, 0); } while (0)
#define PG8_STAGE_AN(bufoff, soff, h, nx) do { _Pragma("unroll") for (int _i = 0; _i < 2; ++_i) \
        __builtin_amdgcn_raw_ptr_buffer_load_lds(rsA, (LAS void*)(lds + (bufoff) + ldsw + _i * 8192), 16, GATHER ? vS[2 * (h) + _i] : voffA, (soff) + (h) * hstepA + _i * pstepA, 0, 0); } while (0)
#define PG8_LDA(dst, b, h) do { _Pragma("unroll") for (int m = 0; m < 4; ++m) _Pragma("unroll") for (int k = 0; k < 2; ++k) dst[m][k] = *(const LAS bf16x8*)(lds + PG8_SA(b, h) + aoff + m * 2048 + k * KOFF); } while (0)
#define PG8_LDB(dst, b, h) do { _Pragma("unroll") for (int n = 0; n < 2; ++n) _Pragma("unroll") for (int k = 0; k < 2; ++k) dst[n][k] = *(const LAS bf16x8*)(lds + PG8_SB(b, h) + boff + n * 2048 + k * KOFF); } while (0)
#define PG8_CAT(x, y) __builtin_shufflevector(__builtin_bit_cast(v4i_t, x), __builtin_bit_cast(v4i_t, y), 0, 1, 2, 3, 4, 5, 6, 7)
#define PG8_MMA(ai, bj, At, Bt) do { __builtin_amdgcn_s_setprio(1); _Pragma("unroll") for (int m = 0; m < 4; ++m) _Pragma("unroll") for (int n = 0; n < 2; ++n) { \
        if constexpr (F8) { const v8i_t b8_ = PG8_CAT(Bt[n][0], Bt[n][1]), a8_ = PG8_CAT(At[m][0], At[m][1]); \
            asm volatile("v_mfma_f32_16x16x128_f8f6f4 %0, %1, %2, %0" : "+v"(acc[ai][bj][m][n]) : "v"(b8_), "v"(a8_)); } \
        else { _Pragma("unroll") for (int k = 0; k < 2; ++k) acc[ai][bj][m][n] = __builtin_amdgcn_mfma_f32_16x16x32_bf16(Bt[n][k], At[m][k], acc[ai][bj][m][n], 0, 0, 0); } } \
        __builtin_amdgcn_s_setprio(0); } while (0)
#define PG8_WAIT_V(n) asm volatile("s_waitcnt vmcnt(" #n ")" ::: "memory")
#define PG8_WAIT_L(n) asm volatile("s_waitcnt lgkmcnt(" #n ")" ::: "memory")
#define PG8_BAR __builtin_amdgcn_s_barrier()
#define PG8_SCHED __builtin_amdgcn_sched_barrier(0)
    Unit cur, nxt; int ui = 0; typename Epi::Pre pf;
    if (!S.next(0, cur)) return;
    f32x4 acc[2][2][4][2];
#pragma unroll
    for (int a = 0; a < 2; ++a)
#pragma unroll
        for (int b = 0; b < 2; ++b)
#pragma unroll
            for (int m = 0; m < 4; ++m)
#pragma unroll
                for (int n = 0; n < 2; ++n) acc[a][b][m][n] = (f32x4){0.f, 0.f, 0.f, 0.f};
    bf16x8 At[4][2], B0[2][2], B1[2][2];
#define PG8_ROT(u_) (((u_).pn & ((nt >> 1) - 1)) << 1)
#define PG8_KOFF(t_) ((unsigned)(((t_) + rotc) & (nt - 1)) * kstep)
    unsigned cA = cur.a, cB = cur.b; int rotc = PG8_ROT(cur);
    const unsigned pA = cA + (unsigned)rotc * kstep, pB = cB + (unsigned)rotc * kstep;
    if constexpr (GATHER) { PG8_LOADROWS_RAW(vN, cur.pm); _Pragma("unroll") for (int _p = 0; _p < 4; ++_p) { vG[_p] = PG8_ROWOFF(vN[_p]); vS[_p] = vG[_p]; } } else { _Pragma("unroll") for (int _p = 0; _p < 4; ++_p) { vG[_p] = 0u; vS[_p] = 0u; vN[_p] = 0u; } }
    if constexpr (SP2) {
        PG8_STAGE_B(PG8_SB(0, 0), pB); PG8_STAGE_B(PG8_SB(0, 1), pB + hstepB); PG8_STAGE_A(PG8_SA(0, 0), pA, 0); PG8_STAGE_A(PG8_SA(0, 1), pA, 1);
        if (wr == 1) PG8_BAR;
        PG8_WAIT_V(2); PG8_BAR;
        PG8_STAGE_B(PG8_SB(1, 0), pB + kstep); PG8_STAGE_A(PG8_SA(1, 0), pA + kstep, 0); PG8_STAGE_B(PG8_SB(1, 1), pB + hstepB + kstep);
        PG8_WAIT_V(6); PG8_BAR;
    } else {
        PG8_STAGE_B(PG8_SB(0, 0), pB); PG8_STAGE_A(PG8_SA(0, 0), pA, 0); PG8_STAGE_B(PG8_SB(0, 1), pB + hstepB); PG8_STAGE_A(PG8_SA(0, 1), pA, 1);
        if (wr == 1) PG8_BAR;
        PG8_WAIT_V(4); PG8_BAR;
        PG8_STAGE_B(PG8_SB(1, 0), pB + kstep); PG8_STAGE_A(PG8_SA(1, 0), pA + kstep, 0); PG8_STAGE_B(PG8_SB(1, 1), pB + hstepB + kstep);
        PG8_WAIT_V(6); PG8_BAR;
    }
    for (;;) {
        const bool has_next = S.next(ui + 1, nxt);
        const unsigned nA0 = has_next ? nxt.a : cA, nB0 = has_next ? nxt.b : cB; const int rotn = has_next ? PG8_ROT(nxt) : rotc;
        const unsigned nA = nA0 + (unsigned)rotn * kstep, nB = nB0 + (unsigned)rotn * kstep;
        if constexpr (GATHER) { if (has_next) { PG8_LOADROWS_RAW(vN, nxt.pm); } }
#define PG8_KITER(LAST_, a1, a2, b2) do { const unsigned a3 = (a2) + kstep, b3 = (b2) + kstep; \
            if constexpr (SP2) { \
            PG8_LDB(B0, 0, 0); PG8_LDB(B1, 0, 1); PG8_SCHED; PG8_LDA(At, 0, 0); PG8_STAGE_A(PG8_SA(1, 1), a1, 1); \
            PG8_WAIT_V(8); PG8_WAIT_L(0); PG8_BAR; PG8_MMA(0, 0, At, B0); PG8_MMA(0, 1, At, B1); PG8_BAR; PG8_SCHED; \
            PG8_LDA(At, 0, 1); PG8_STAGE_B(PG8_SB(0, 0), b2); PG8_STAGE_B(PG8_SB(0, 1), b2 + hstepB); PG8_STAGE_AN(PG8_SA(0, 0), a2, 0, LAST_); \
            PG8_WAIT_V(8); PG8_WAIT_L(0); PG8_BAR; PG8_MMA(1, 0, At, B0); PG8_MMA(1, 1, At, B1); PG8_BAR; PG8_SCHED; \
            PG8_LDB(B0, 1, 0); PG8_LDB(B1, 1, 1); PG8_SCHED; PG8_LDA(At, 1, 0); PG8_STAGE_AN(PG8_SA(0, 1), a2, 1, LAST_); \
            PG8_WAIT_V(8); PG8_WAIT_L(0); PG8_BAR; PG8_MMA(0, 0, At, B0); PG8_MMA(0, 1, At, B1); PG8_BAR; PG8_SCHED; \
            PG8_LDA(At, 1, 1); PG8_STAGE_B(PG8_SB(1, 0), b3); PG8_STAGE_B(PG8_SB(1, 1), b3 + hstepB); PG8_STAGE_AN(PG8_SA(1, 0), a3, 0, LAST_); \
            PG8_WAIT_V(8); PG8_WAIT_L(0); PG8_BAR; PG8_MMA(1, 0, At, B0); PG8_MMA(1, 1, At, B1); PG8_BAR; PG8_SCHED; \
            } else { \
            PG8_LDB(B0, 0, 0); PG8_SCHED; PG8_LDA(At, 0, 0); PG8_STAGE_A(PG8_SA(1, 1), a1, 1); \
            PG8_WAIT_L(8); PG8_BAR; PG8_WAIT_L(0); PG8_MMA(0, 0, At, B0); PG8_BAR; PG8_SCHED; \
            PG8_LDB(B1, 0, 1); PG8_STAGE_B(PG8_SB(0, 0), b2); \
            PG8_BAR; PG8_WAIT_L(0); PG8_MMA(0, 1, At, B1); PG8_BAR; \
            PG8_LDA(At, 0, 1); PG8_STAGE_AN(PG8_SA(0, 0), a2, 0, LAST_); \
            PG8_BAR; PG8_WAIT_L(0); PG8_MMA(1, 0, At, B0); PG8_BAR; PG8_SCHED; \
            PG8_STAGE_B(PG8_SB(0, 1), b2 + hstepB); \
            PG8_WAIT_V(6); PG8_BAR; PG8_MMA(1, 1, At, B1); PG8_BAR; \
            PG8_LDB(B0, 1, 0); PG8_SCHED; PG8_LDA(At, 1, 0); PG8_STAGE_AN(PG8_SA(0, 1), a2, 1, LAST_); \
            PG8_WAIT_L(8); PG8_BAR; PG8_WAIT_L(0); PG8_MMA(0, 0, At, B0); PG8_BAR; PG8_SCHED; \
            PG8_LDB(B1, 1, 1); PG8_STAGE_B(PG8_SB(1, 0), b3); \
            PG8_BAR; PG8_WAIT_L(0); PG8_MMA(0, 1, At, B1); PG8_BAR; \
            PG8_LDA(At, 1, 1); PG8_STAGE_AN(PG8_SA(1, 0), a3, 0, LAST_); \
            PG8_BAR; PG8_WAIT_L(0); PG8_MMA(1, 0, At, B0); PG8_BAR; PG8_SCHED; \
            PG8_STAGE_B(PG8_SB(1, 1), b3 + hstepB); \
            PG8_WAIT_V(6); PG8_BAR; PG8_MMA(1, 1, At, B1); PG8_BAR; \
            } \
        } while (0)
#pragma nounroll
        for (int t = 0; t < nt - 2; t += 2) { const unsigned a1_ = cA + PG8_KOFF(t) + kstep, a2_ = cA + PG8_KOFF(t + 2), b2_ = cB + PG8_KOFF(t + 2); PG8_KITER(false, a1_, a2_, b2_); }
        { if constexpr (GATHER) { if (has_next) { asm volatile("; next unit's rows" : "+v"(vN[0]), "+v"(vN[1]), "+v"(vN[2]), "+v"(vN[3])); _Pragma("unroll") for (int _p = 0; _p < 4; ++_p) vS[_p] = PG8_ROWOFF(vN[_p]); } }
          { int fr_p = fr, fq_p = fq; asm volatile("" : "+v"(fr_p), "+v"(fq_p)); E.prefetch(cur, wr, wc, fr_p, fq_p, pf); }
          const unsigned a1_ = cA + PG8_KOFF(nt - 2) + kstep; PG8_KITER(true, a1_, nA, nB); }
#undef PG8_KITER
        if constexpr (ALIGN_EPI) { if (wr == 0) PG8_BAR; }
        if constexpr (F8) asm volatile("s_nop 15\n\ts_nop 15" ::: "memory");
        { int fr_e = fr, fq_e = fq; asm volatile("" : "+v"(fr_e), "+v"(fq_e));
          E(acc, cur, wr, wc, fr_e, fq_e, lds + RING_BYTES, wid, lane, pf); }
        if (!has_next) break;
#pragma unroll
        for (int a = 0; a < 2; ++a)
#pragma unroll
            for (int b = 0; b < 2; ++b)
#pragma unroll
                for (int m = 0; m < 4; ++m)
#pragma unroll
                    for (int n = 0; n < 2; ++n) { unsigned long long z0_, z1_; asm("v_mov_b64 %0, 0" : "=v"(z0_)); asm("v_mov_b64 %0, 0" : "=v"(z1_)); acc[a][b][m][n] = __builtin_bit_cast(f32x4, (u64x2_t){z0_, z1_}); }
        cur = nxt; cA = nA0; cB = nB0; rotc = rotn; ++ui;
        if constexpr (GATHER) { vG[0] = vS[0]; vG[1] = vS[1]; vG[2] = vS[2]; vG[3] = vS[3]; }
        if constexpr (ALIGN_EPI) { if (wr == 1) PG8_BAR; }
    }
    PG8_WAIT_V(0);
    if constexpr (!ALIGN_EPI) { if (wr == 0) PG8_BAR; }
    PG8_BAR;
#undef PG8_ROT
#undef PG8_KOFF
#undef PG8_SA
#undef PG8_SB
#undef PG8_STAGE_A
#undef PG8_STAGE_AN
#undef PG8_LOADROWS_RAW
#undef PG8_ROWOFF
#undef PG8_STAGE_B
#undef PG8_LDA
#undef PG8_LDB
#undef PG8_MMA
#undef PG8_CAT
#undef PG8_WAIT_V
#undef PG8_WAIT_L
#undef PG8_BAR
#undef PG8_SCHED
}
}
using pg8::Unit;
typedef f32x4 AccT[2][2][4][2];

#define EROW(ai, m) ((ai) * 128 + wr * 64 + (m) * 16 + fr)
#define ECOLW(bj) (wc * 64 + (bj) * 32 + 8 * fq)
__device__ __forceinline__ unsigned dpp_ror8(unsigned v) { return (unsigned)__builtin_amdgcn_update_dpp(0, (int)v, 0x128, 0xf, 0xf, false); }
__device__ __forceinline__ void wide16_rows(const u32x4 a, const u32x4 b, int fr, u32x4& lo, u32x4& hi) {
    const bool up = fr >= 8; u32x4 snd, rcv;
#pragma unroll
    for (int q = 0; q < 4; ++q) { snd[q] = up ? a[q] : b[q]; rcv[q] = dpp_ror8(snd[q]); }
#pragma unroll
    for (int q = 0; q < 4; ++q) { lo[q] = up ? rcv[q] : a[q]; hi[q] = up ? b[q] : rcv[q]; }
}
__device__ __forceinline__ u32x4 wide8_pair(u32x2 a, u32x2 b) {
    const auto r0 = __builtin_amdgcn_permlane16_swap(a.x, b.x, false, false); const auto r1 = __builtin_amdgcn_permlane16_swap(a.y, b.y, false, false);
    u32x4 o; o.x = r0[0]; o.y = r1[0]; o.z = r0[1]; o.w = r1[1]; return o; }

#define ECOL(bj) ((bj) * 128 + wc * 32 + 8 * fq)
__device__ __forceinline__ u32x4 pack8(const f32x4 v0, const f32x4 v1) { u32x4 w; w.x = cvt_pk_bf16(v0[0], v0[1]); w.y = cvt_pk_bf16(v0[2], v0[3]); w.z = cvt_pk_bf16(v1[0], v1[1]); w.w = cvt_pk_bf16(v1[2], v1[3]); return w; }

struct EpiStore {
    struct Pre {}; __device__ __forceinline__ void prefetch(const Unit&, int, int, int, int, Pre&) const {}
    int ldc;
    __device__ __forceinline__ void operator()(const AccT& acc, const Unit& u, int wr, int wc, int fr, int fq, LAS unsigned char*, int, int, const Pre& pf) const {
        bf16_t* base = (bf16_t*)u.o;
#pragma unroll
        for (int ai = 0; ai < 2; ++ai)
#pragma unroll
            for (int m = 0; m < 4; ++m) { bf16_t* rowp = base + (size_t)EROW(ai, m) * ldc + ECOL(0);
#pragma unroll
                for (int bj = 0; bj < 2; ++bj) *(u32x4*)(rowp + bj * 128) = pack8(acc[ai][bj][m][0], acc[ai][bj][m][1]); }
    }
};
struct EpiStore8 {
    struct Pre {}; __device__ __forceinline__ void prefetch(const Unit&, int, int, int, int, Pre&) const {}
    int ldc;
    __device__ __forceinline__ void operator()(const AccT& acc, const Unit& u, int wr, int wc, int fr, int fq, LAS unsigned char*, int, int, const Pre& pf) const {
        unsigned char* base = (unsigned char*)u.o;
#pragma unroll
        for (int ai = 0; ai < 2; ++ai)
#pragma unroll
            for (int m = 0; m < 4; ++m) { unsigned char* rowp = base + (size_t)EROW(ai, m) * ldc + ECOL(0);
#pragma unroll
                for (int bj = 0; bj < 2; ++bj) { f32x4 v0 = acc[ai][bj][m][0], v1 = acc[ai][bj][m][1];
#pragma unroll
                    for (int q = 0; q < 4; ++q) { v0[q] = __builtin_amdgcn_fmed3f(v0[q], -440.f, 440.f); v1[q] = __builtin_amdgcn_fmed3f(v1[q], -440.f, 440.f); }
                    u32x2 q8; q8.x = pk4_fp8(v0[0], v0[1], v0[2], v0[3]); q8.y = pk4_fp8(v1[0], v1[1], v1[2], v1[3]); *(u32x2*)(rowp + bj * 128) = q8; } }
    }
};
struct EpiProj {
    struct Pre { float rs[8]; };
    __device__ __forceinline__ void prefetch(const Unit& u, int wr, int wc, int fr, int fq, Pre& p) const {
        const size_t r0 = (size_t)u.pm * 256;
#pragma unroll
        for (int ai = 0; ai < 2; ++ai)
#pragma unroll
            for (int m = 0; m < 4; ++m) p.rs[ai * 4 + m] = rstd0[r0 + EROW(ai, m)];
    }
    bf16_t* proj; const float* rstd0;
    __device__ __forceinline__ void operator()(const AccT& acc, const Unit& u, int wr, int wc, int fr, int fq, LAS unsigned char*, int, int, const Pre& pf) const {
        const size_t r0 = (size_t)u.pm * 256;
        if (u.pn < 4) {
#pragma unroll
            for (int ai = 0; ai < 2; ++ai)
#pragma unroll
                for (int m = 0; m < 4; ++m) { const size_t row = r0 + EROW(ai, m); const float rs = pf.rs[ai * 4 + m]; bf16_t* rowp = proj + row * PROJW + u.pn * 256 + ECOL(0);
#pragma unroll
                    for (int bj = 0; bj < 2; ++bj) *(u32x4*)(rowp + bj * 128) = pack8(acc[ai][bj][m][0] * rs, acc[ai][bj][m][1] * rs); }
        } else {
#pragma unroll
            for (int ai = 0; ai < 2; ++ai)
#pragma unroll
                for (int m = 0; m < 4; ++m) { const size_t row = r0 + EROW(ai, m); const float rs = pf.rs[ai * 4 + m]; const float rs2 = rs * rs;
                    *(u32x4*)(proj + row * PROJW + 2 * CONVW + (u.pn - 4) * 128 + wc * 32 + 8 * fq) = pack8(acc[ai][0][m][0] * acc[ai][1][m][0] * rs2, acc[ai][0][m][1] * acc[ai][1][m][1] * rs2); }
        }
    }
};
struct EpiOutProj {
    struct Pre {}; __device__ __forceinline__ void prefetch(const Unit&, int, int, int, int, Pre&) const {}
    const bf16_t* xb; bf16_t* h1b; float* ss1; unsigned char* h1q;
    __device__ __forceinline__ void operator()(const AccT& acc, const Unit& u, int wr, int wc, int fr, int fq, LAS unsigned char*, int, int, const Pre& pf) const {
        const size_t r0 = (size_t)u.pm * 256; const int c0 = u.pn * 256 + ECOLW(0);
        const int cst = u.pn * 256 + wc * 64 + 8 * (fq + 4 * (fr >> 3));
#pragma unroll
        for (int ai = 0; ai < 2; ++ai)
#pragma unroll
            for (int m = 0; m < 4; ++m) { const size_t row = r0 + EROW(ai, m); const size_t off = row * D + c0; float ss = 0.f; u32x4 pk[2]; u32x2 h8[2];
#pragma unroll
                for (int bj = 0; bj < 2; ++bj) {
                    const u32x4 xw = *(const u32x4*)(xb + off + bj * 32); f32x4 v0 = acc[ai][bj][m][0], v1 = acc[ai][bj][m][1];
                    v0[0] += bflo(xw.x); v0[1] += bfhi(xw.x); v0[2] += bflo(xw.y); v0[3] += bfhi(xw.y); v1[0] += bflo(xw.z); v1[1] += bfhi(xw.z); v1[2] += bflo(xw.w); v1[3] += bfhi(xw.w);
                    pk[bj] = pack8(v0, v1);
                    { f32x4 c0_ = v0, c1_ = v1;
#pragma unroll
                      for (int q = 0; q < 4; ++q) { c0_[q] = __builtin_amdgcn_fmed3f(c0_[q], -440.f, 440.f); c1_[q] = __builtin_amdgcn_fmed3f(c1_[q], -440.f, 440.f); }
                      h8[bj].x = pk4_fp8(c0_[0], c0_[1], c0_[2], c0_[3]); h8[bj].y = pk4_fp8(c1_[0], c1_[1], c1_[2], c1_[3]); }
                    ss += (v0[0] * v0[0] + v0[1] * v0[1]) + (v0[2] * v0[2] + v0[3] * v0[3]) + (v1[0] * v1[0] + v1[1] * v1[1]) + (v1[2] * v1[2] + v1[3] * v1[3]); }
                u32x4 lo, hi; wide16_rows(pk[0], pk[1], fr, lo, hi);
                bf16_t* rp = h1b + (r0 + (size_t)(ai * 128 + wr * 64 + m * 16 + (fr & 7))) * D + cst;
                *(u32x4*)rp = lo; *(u32x4*)(rp + 8 * D) = hi;
                *(u32x4*)(h1q + row * D + u.pn * 256 + wc * 64 + 32 * (fq & 1) + 8 * (fq & 2)) = wide8_pair(h8[0], h8[1]);
                ss += __shfl_xor(ss, 16); ss += __shfl_xor(ss, 32);
                if (fq == 0) ss1[row * 16 + u.pn * 4 + wc] = ss;
                if (m == 3) asm volatile("" ::: "memory"); }
    }
};
struct EpiSoftmax {
    struct Pre {}; __device__ __forceinline__ void prefetch(const Unit&, int, int, int, int, Pre&) const {}
    int ldc; const float* ss1; float qscale;
    __device__ __forceinline__ void operator()(AccT& acc, const Unit& u, int wr, int wc, int fr, int fq, LAS unsigned char* ldsx, int, int, const Pre& pf) const {
        LAS float* XM = (LAS float*)ldsx;
        LAS float* XS = (LAS float*)(ldsx + 4096);
#pragma unroll
        for (int ai = 0; ai < 2; ++ai)
#pragma unroll
            for (int m = 0; m < 4; ++m) { float mx = -INFINITY;
                { const f32x4* sp = (const f32x4*)(ss1 + ((size_t)u.pm * 256 + EROW(ai, m)) * 16); const f32x4 s0 = sp[0], s1 = sp[1], s2 = sp[2], s3 = sp[3];
                  const float tot = ((s0[0] + s0[1]) + (s0[2] + s0[3])) + ((s1[0] + s1[1]) + (s1[2] + s1[3])) + ((s2[0] + s2[1]) + (s2[2] + s2[3])) + ((s3[0] + s3[1]) + (s3[2] + s3[3]));
                  const float sc = qscale / sqrtf(tot * (1.0f / D) + RMS_EPS);
#pragma unroll
                  for (int bj = 0; bj < 2; ++bj)
#pragma unroll
                      for (int n = 0; n < 2; ++n) acc[ai][bj][m][n] = acc[ai][bj][m][n] * sc; }
#pragma unroll
                for (int bj = 0; bj < 2; ++bj)
#pragma unroll
                    for (int n = 0; n < 2; ++n) { const f32x4 v = acc[ai][bj][m][n]; mx = fmaxf(mx, fmaxf(fmaxf(v[0], v[1]), fmaxf(v[2], v[3]))); }
                mx = fmaxf(mx, __shfl_xor(mx, 16)); mx = fmaxf(mx, __shfl_xor(mx, 32));
                if (fq == 0) XM[EROW(ai, m) * 4 + wc] = mx; }
        LDS_WAIT(); __builtin_amdgcn_s_barrier(); asm volatile("" ::: "memory");
#pragma unroll
        for (int ai = 0; ai < 2; ++ai)
#pragma unroll
            for (int m = 0; m < 4; ++m) { const f32x4 mv = *(const LAS f32x4*)(XM + EROW(ai, m) * 4); const float mx = fmaxf(fmaxf(mv[0], mv[1]), fmaxf(mv[2], mv[3])); float s = 0.f;
#pragma unroll
                for (int bj = 0; bj < 2; ++bj)
#pragma unroll
                    for (int n = 0; n < 2; ++n) { f32x4 v = acc[ai][bj][m][n];
                        v[0] = __builtin_amdgcn_exp2f(v[0] - mx); v[1] = __builtin_amdgcn_exp2f(v[1] - mx); v[2] = __builtin_amdgcn_exp2f(v[2] - mx); v[3] = __builtin_amdgcn_exp2f(v[3] - mx);
                        acc[ai][bj][m][n] = v; s += (v[0] + v[1]) + (v[2] + v[3]); }
                s += __shfl_xor(s, 16); s += __shfl_xor(s, 32);
                if (fq == 0) XS[EROW(ai, m) * 4 + wc] = s; }
        LDS_WAIT(); __builtin_amdgcn_s_barrier(); asm volatile("" ::: "memory");
        unsigned char* base = (unsigned char*)u.o;
#pragma unroll
        for (int ai = 0; ai < 2; ++ai)
#pragma unroll
            for (int m = 0; m < 4; ++m) { const f32x4 sv = *(const LAS f32x4*)(XS + EROW(ai, m) * 4); const float inv = P8_SCALE / ((sv[0] + sv[1]) + (sv[2] + sv[3]));
                unsigned char* rowp = base + (size_t)EROW(ai, m) * ldc + wc * 64 + 32 * (fq & 1) + 8 * (fq & 2); u32x2 q8[2];
#pragma unroll
                for (int bj = 0; bj < 2; ++bj) { const f32x4 v0 = acc[ai][bj][m][0] * inv, v1 = acc[ai][bj][m][1] * inv;
                    q8[bj].x = pk4_fp8(v0[0], v0[1], v0[2], v0[3]); q8[bj].y = pk4_fp8(v1[0], v1[1], v1[2], v1[3]); }
                *(u32x4*)rowp = wide8_pair(q8[0], q8[1]); }
    }
};
struct EpiWo {
    struct Pre {}; __device__ __forceinline__ void prefetch(const Unit&, int, int, int, int, Pre&) const {}
    const bf16_t* hb; bf16_t* ho; unsigned char* h2q;
    __device__ __forceinline__ void operator()(const AccT& acc, const Unit& u, int wr, int wc, int fr, int fq, LAS unsigned char*, int, int, const Pre& pf) const {
        const size_t r0 = (size_t)u.pm * 256; const int c0 = u.pn * 256 + ECOLW(0);
        const int cst = u.pn * 256 + wc * 64 + 8 * (fq + 4 * (fr >> 3));
#pragma unroll
        for (int ai = 0; ai < 2; ++ai)
#pragma unroll
            for (int m = 0; m < 4; ++m) { const size_t off = (r0 + EROW(ai, m)) * D + c0; u32x4 pk[2], h8[2];
#pragma unroll
                for (int bj = 0; bj < 2; ++bj) { const u32x4 hw = *(const u32x4*)(hb + off + bj * 32);
                    f32x4 v0 = acc[ai][bj][m][0] * P8_INV, v1 = acc[ai][bj][m][1] * P8_INV;
                    v0[0] += bflo(hw.x); v0[1] += bfhi(hw.x); v0[2] += bflo(hw.y); v0[3] += bfhi(hw.y); v1[0] += bflo(hw.z); v1[1] += bfhi(hw.z); v1[2] += bflo(hw.w); v1[3] += bfhi(hw.w);
                    pk[bj] = pack8(v0, v1);
                    f32x4 c0_ = v0, c1_ = v1;
#pragma unroll
                    for (int q = 0; q < 4; ++q) { c0_[q] = __builtin_amdgcn_fmed3f(c0_[q], -440.f, 440.f); c1_[q] = __builtin_amdgcn_fmed3f(c1_[q], -440.f, 440.f); }
                    h8[bj].x = pk4_fp8(c0_[0], c0_[1], c0_[2], c0_[3]); h8[bj].y = pk4_fp8(c1_[0], c1_[1], c1_[2], c1_[3]); h8[bj].z = 0u; h8[bj].w = 0u; }
                u32x4 lo, hi; wide16_rows(pk[0], pk[1], fr, lo, hi);
                bf16_t* rp = ho + (r0 + (size_t)(ai * 128 + wr * 64 + m * 16 + (fr & 7))) * D + cst;
                *(u32x4*)rp = lo; *(u32x4*)(rp + 8 * D) = hi;
                *(u32x4*)(h2q + (r0 + EROW(ai, m)) * D + u.pn * 256 + wc * 64 + 32 * (fq & 1) + 8 * (fq & 2)) = wide8_pair((u32x2){h8[0].x, h8[0].y}, (u32x2){h8[1].x, h8[1].y}); }
    }
};
struct EpiGateUp {
    const float* rs_slot; const float* bgu_all; unsigned char* act;
    struct Pre { float rs[8]; f32x4 b[4]; };
    __device__ __forceinline__ void prefetch(const Unit& u, int wr, int wc, int fr, int fq, Pre& p) const {
        const int cc = u.pn * 128 + wc * 32 + 8 * fq; const float* bgu = bgu_all + (size_t)u.ex * 2 * DFF; const size_t slot0 = (size_t)u.pm * 256;
#pragma unroll
        for (int ai = 0; ai < 2; ++ai)
#pragma unroll
            for (int m = 0; m < 4; ++m) p.rs[ai * 4 + m] = rs_slot[slot0 + EROW(ai, m)];
        p.b[0] = *(const f32x4*)(bgu + cc); p.b[1] = *(const f32x4*)(bgu + cc + 4); p.b[2] = *(const f32x4*)(bgu + DFF + cc); p.b[3] = *(const f32x4*)(bgu + DFF + cc + 4);
    }
    static __device__ __forceinline__ f32x2 swiglu_c2(f32x2 g, f32x2 l1) {
        f32x2 t, xl, e, r;
        t.x = fminf(g.x, 7.0f * GLU_C); t.y = fminf(g.y, 7.0f * GLU_C);
        xl.x = __builtin_amdgcn_fmed3f(l1.x, -6.0f, 8.0f); xl.y = __builtin_amdgcn_fmed3f(l1.y, -6.0f, 8.0f);
        e.x = __builtin_amdgcn_exp2f(-t.x); e.y = __builtin_amdgcn_exp2f(-t.y);
        const f32x2 d = e + (f32x2){1.0f, 1.0f};
        r.x = __builtin_amdgcn_rcpf(d.x); r.y = __builtin_amdgcn_rcpf(d.y);
        return (t * r) * xl;
    }
    __device__ __forceinline__ void operator()(const AccT& acc, const Unit& u, int wr, int wc, int fr, int fq, LAS unsigned char*, int, int, const Pre& pf) const {
        const int cc = u.pn * 128 + wc * 32 + 8 * fq; const float* bgu = bgu_all + (size_t)u.ex * 2 * DFF; const size_t slot0 = (size_t)u.pm * 256;
        const f32x4 bg0 = pf.b[0] * GLU_C, bg1 = pf.b[1] * GLU_C, bl0 = pf.b[2] + 1.0f, bl1 = pf.b[3] + 1.0f;
#pragma unroll
        for (int ai = 0; ai < 2; ++ai)
#pragma unroll
            for (int mp = 0; mp < 2; ++mp) { u32x2 q8[2];
#pragma unroll
                for (int mh = 0; mh < 2; ++mh) { const int m = 2 * mp + mh; const int r = EROW(ai, m); const float rs = pf.rs[ai * 4 + m] * W8_INV;
                    const f32x2 rs2 = {rs, rs};
#define GU2(v_, h_) ((f32x2){(v_)[2 * (h_)], (v_)[2 * (h_) + 1]})
                    f32x4 a0, a1;
#pragma unroll
                    for (int h = 0; h < 2; ++h) {
                        const f32x2 g0 = __builtin_elementwise_fma(GU2(acc[ai][0][m][0], h), rs2, GU2(bg0, h)), l0 = __builtin_elementwise_fma(GU2(acc[ai][1][m][0], h), rs2, GU2(bl0, h));
                        const f32x2 g1 = __builtin_elementwise_fma(GU2(acc[ai][0][m][1], h), rs2, GU2(bg1, h)), l1 = __builtin_elementwise_fma(GU2(acc[ai][1][m][1], h), rs2, GU2(bl1, h));
                        const f32x2 o0 = swiglu_c2(g0, l0), o1 = swiglu_c2(g1, l1);
                        a0[2 * h] = o0.x; a0[2 * h + 1] = o0.y; a1[2 * h] = o1.x; a1[2 * h + 1] = o1.y; }
#undef GU2
                    q8[mh].x = pk4_fp8(a0[0], a0[1], a0[2], a0[3]); q8[mh].y = pk4_fp8(a1[0], a1[1], a1[2], a1[3]); }
                const int rr = EROW(ai, 2 * mp + (fq & 1));
                *(u32x4*)(act + (slot0 + rr) * DFF + u.pn * 128 + wc * 32 + 8 * (fq & 2)) = wide8_pair(q8[0], q8[1]); }
    }
};
struct EpiDown {
    const float* gate_slot; const float* bd_all; unsigned char* Y;
    struct Pre { float g[8]; f32x4 b[4]; };
    __device__ __forceinline__ void prefetch(const Unit& u, int wr, int wc, int fr, int fq, Pre& p) const {
        const int c0 = u.pn * 256 + ECOLW(0); const float* bd = bd_all + (size_t)u.ex * D; const size_t slot0 = (size_t)u.pm * 256;
#pragma unroll
        for (int ai = 0; ai < 2; ++ai)
#pragma unroll
            for (int m = 0; m < 4; ++m) p.g[ai * 4 + m] = gate_slot[slot0 + EROW(ai, m)];
#pragma unroll
        for (int bj = 0; bj < 2; ++bj) { p.b[2 * bj] = *(const f32x4*)(bd + c0 + bj * 32); p.b[2 * bj + 1] = *(const f32x4*)(bd + c0 + bj * 32 + 4); }
    }
    __device__ __forceinline__ void operator()(const AccT& acc, const Unit& u, int wr, int wc, int fr, int fq, LAS unsigned char*, int, int, const Pre& pf) const {
        const int c0 = u.pn * 256 + ECOLW(0); const float* bd = bd_all + (size_t)u.ex * D; const size_t slot0 = (size_t)u.pm * 256;
        const int cst = u.pn * 256 + wc * 64 + 32 * (fq & 1) + 8 * (fq & 2);
        f32x4 bv[2][2];
#pragma unroll
        for (int bj = 0; bj < 2; ++bj) { bv[bj][0] = pf.b[2 * bj]; bv[bj][1] = pf.b[2 * bj + 1]; }
#pragma unroll
        for (int ai = 0; ai < 2; ++ai)
#pragma unroll
            for (int m = 0; m < 4; ++m) { const int r = EROW(ai, m); const float g = pf.g[ai * 4 + m] * Y8_SCALE; u32x2 q8[2];
#pragma unroll
                for (int bj = 0; bj < 2; ++bj) { f32x4 v0 = (acc[ai][bj][m][0] * W8_INV + bv[bj][0]) * g, v1 = (acc[ai][bj][m][1] * W8_INV + bv[bj][1]) * g;
#pragma unroll
                    for (int q = 0; q < 4; ++q) { v0[q] = __builtin_amdgcn_fmed3f(v0[q], -440.f, 440.f); v1[q] = __builtin_amdgcn_fmed3f(v1[q], -440.f, 440.f); }
                    q8[bj].x = pk4_fp8(v0[0], v0[1], v0[2], v0[3]); q8[bj].y = pk4_fp8(v1[0], v1[1], v1[2], v1[3]); }
                *(u32x4*)(Y + (slot0 + r) * D + cst) = wide8_pair(q8[0], q8[1]); }
    }
};

struct SchedDense {
    const LAS int* utab; char* O; unsigned lda2, ldb2; size_t ldo2;
    __device__ __forceinline__ bool next(int i, Unit& u) const {
        const int v_ = __builtin_amdgcn_readfirstlane(utab[i]); if (v_ < 0) return false; const int pm = v_ & 0xffff, pn = v_ >> 16;
        u.pm = pm; u.pn = pn; u.ex = 0; u.a = (unsigned)pm * 256u * lda2; u.b = (unsigned)pn * 256u * ldb2; u.o = O ? O + (size_t)pm * 256 * ldo2 + (size_t)pn * 512 : nullptr; return true;
    }
};
struct SchedScores {
    const LAS int* utab; char* P;
    __device__ __forceinline__ bool next(int i, Unit& u) const {
        const int v_ = __builtin_amdgcn_readfirstlane(utab[i]); if (v_ < 0) return false; const int pm = v_ & 0xffff, pn = v_ >> 16;
        u.pm = pm; u.pn = pn; u.ex = 0; const int b = pm / (SEQ / 256);
        u.a = (unsigned)pm * 256u * D; u.b = (unsigned)(b * NHEAD + pn) * 256u * D; u.o = P + ((size_t)pm * 256 * D + pn * HDIM); return true;
    }
};
struct SchedAttnOut {
    const LAS int* utab;
    __device__ __forceinline__ bool next(int i, Unit& u) const {
        const int v_ = __builtin_amdgcn_readfirstlane(utab[i]); if (v_ < 0) return false; const int pm = v_ & 0xffff, pn = v_ >> 16;
        u.pm = pm; u.pn = pn; u.ex = 0; const int b = pm / (SEQ / 256);
        u.a = (unsigned)pm * 256u * D; u.b = (unsigned)(b * D + pn * 256) * (unsigned)D; u.o = nullptr; return true;
    }
};
struct SchedList {
    int first, n; unsigned a0, bstep; char* O; unsigned astep = 0u; size_t ostep = 0;
    __device__ __forceinline__ bool next(int i, Unit& u) const {
        if (i >= n) return false; u.pm = 0; u.pn = first + i; u.ex = 0; u.a = a0 + (unsigned)(first + i) * astep; u.b = (unsigned)(first + i) * bstep; u.o = O + (size_t)(first + i) * ostep; return true;
    }
};

struct SchedMoe {
    const LAS int* utab; unsigned bexp; const LAS unsigned char* tile_e; unsigned astep;
    __device__ __forceinline__ bool next(int i, Unit& u) const {
        const int v = __builtin_amdgcn_readfirstlane(utab[i]); if (v < 0) return false;
        const int pm = v & 0x7ff, pn = (v >> 11) & 7, e = v >> 14;
        u.pm = pm; u.pn = pn; u.ex = e; u.a = (unsigned)pm * astep; u.b = (unsigned)e * bexp + (unsigned)pn * 256u * 1024u; u.o = nullptr; return true;
    }
};
#define XB_TMO      128
#define XB_XCNT(j)  (256  + 64 * (j))
#define XB_XSUB(j)  (1280 + 64 * (j))
#define XB_XGEN(j)  (2304 + 64 * (j))
#define XB_TOP      3328
#define XB_TOPGEN   3392
#define XB_LSUB(j)  (3456 + 64 * (j))
#define XB_LGEN(j)  (4480 + 64 * (j))
#define XCD_BAR_WORDS 5504
#define XB_SPIN_CAP (1u << 20)
__device__ __forceinline__ unsigned xb_ld(unsigned* p)              { return __hip_atomic_load(p, __ATOMIC_RELAXED, __HIP_MEMORY_SCOPE_AGENT); }
__device__ __forceinline__ unsigned xb_add(unsigned* p, unsigned v) { return __hip_atomic_fetch_add(p, v, __ATOMIC_RELAXED, __HIP_MEMORY_SCOPE_AGENT); }
__device__ __forceinline__ unsigned xb_xcc_id() { return (unsigned)__builtin_amdgcn_s_getreg((3 << 11) | 20) & 0xFu; }
#define XB_SPIN(cond, bar) do { unsigned _sp = 0; while (cond) { __builtin_amdgcn_s_sleep(1); \
    if ((++_sp & 255u) == 0u) { if (xb_ld(&(bar)[XB_TMO])) break; if (_sp > XB_SPIN_CAP) { atomicAdd(&(bar)[XB_TMO], 1u); break; } } } } while (0)
struct XcdBarrier { unsigned* bar; unsigned x; volatile LAS unsigned* st; };
__device__ __forceinline__ XcdBarrier xcd_barrier_post(unsigned* bar, volatile LAS unsigned* st) {
    XcdBarrier b; b.bar = bar; b.x = xb_xcc_id(); b.st = st;
    if (threadIdx.x == 0) st[2] = xb_add(&bar[XB_XCNT(b.x)], 1u);
    return b;
}
__device__ __forceinline__ void xcd_barrier_complete(unsigned* bar, unsigned x, unsigned& nloc, unsigned& nx, unsigned& even32) {
    const unsigned G = gridDim.x * gridDim.y * gridDim.z;
    unsigned sum, cnt, mine, sp = 0u;
    for (;;) {
        sum = 0u; cnt = 0u; mine = 0u; even32 = 1u;
#pragma unroll
        for (unsigned j = 0; j < 16; ++j) { const unsigned c = xb_ld(&bar[XB_XCNT(j)]); sum += c; cnt += (c > 0u) ? 1u : 0u; mine = (j == x) ? c : mine; if (c != 0u && c != 32u) even32 = 0u; if (j >= 8u && c != 0u) even32 = 0u; }
        if (sum == G) break;
        __builtin_amdgcn_s_sleep(1);
        if ((++sp & 255u) == 0u) { if (xb_ld(&bar[XB_TMO])) break; if (sp > XB_SPIN_CAP) { atomicAdd(&bar[XB_TMO], 1u); break; } }
    }
    nloc = mine > 0u ? mine : 1u; nx = cnt > 0u ? cnt : 1u;
}
__device__ __forceinline__ void xcd_barrier(const XcdBarrier& b) {
    asm volatile("s_waitcnt vmcnt(0)" ::: "memory");
    __syncthreads();
    if (threadIdx.x == 0) {
        unsigned* bar = b.bar;
        __builtin_amdgcn_s_waitcnt(0);
        unsigned nloc = b.st[0], nx = b.st[1];
        if (nloc == 0u) { unsigned e32 = 0u; xcd_barrier_complete(bar, b.x, nloc, nx, e32); b.st[0] = nloc; b.st[1] = nx; b.st[3] = (e32 != 0u && nx == 8u) ? 1u : 0u; }
        const unsigned old = xb_add(&bar[XB_XSUB(b.x)], 1u);
        const unsigned gen = old / nloc;
        if (old + 1u == (gen + 1u) * nloc) {
            __builtin_amdgcn_fence(__ATOMIC_RELEASE, "agent");
            asm volatile("s_waitcnt vmcnt(0)" ::: "memory");
            const unsigned og = xb_add(&bar[XB_TOP], 1u);
            const unsigned tg = og / nx;
            if (og + 1u == (tg + 1u) * nx) xb_add(&bar[XB_TOPGEN], 1u);
            else XB_SPIN(xb_ld(&bar[XB_TOPGEN]) == tg, bar);
            __builtin_amdgcn_fence(__ATOMIC_ACQUIRE, "agent");
            xb_add(&bar[XB_XGEN(b.x)], 1u);
            asm volatile("s_waitcnt vmcnt(0)" ::: "memory");
        } else {
            XB_SPIN(xb_ld(&bar[XB_XGEN(b.x)]) == gen, bar);
            __builtin_amdgcn_fence(__ATOMIC_ACQUIRE, "agent");
            asm volatile("s_waitcnt vmcnt(0)" ::: "memory");
        }
    }
    __syncthreads();
}
__device__ __forceinline__ void xcd_local_barrier(const XcdBarrier& b) {
    asm volatile("s_waitcnt vmcnt(0)" ::: "memory");
    __syncthreads();
    if (threadIdx.x == 0) {
        unsigned* bar = b.bar;
        __builtin_amdgcn_s_waitcnt(0);
        const unsigned nloc = b.st[0];
        const unsigned old = xb_add(&bar[XB_LSUB(b.x)], 1u);
        const unsigned gen = old / nloc;
        if (old + 1u == (gen + 1u) * nloc) xb_add(&bar[XB_LGEN(b.x)], 1u);
        else XB_SPIN(xb_ld(&bar[XB_LGEN(b.x)]) == gen, bar);
        __builtin_amdgcn_fence(__ATOMIC_ACQUIRE, "agent");
        asm volatile("s_waitcnt vmcnt(0)" ::: "memory");
    }
    __syncthreads();
}
__device__ __forceinline__ void wg_self_sync() {
    asm volatile("s_waitcnt vmcnt(0)" ::: "memory");
    __syncthreads();
    if (threadIdx.x == 0) { __builtin_amdgcn_fence(__ATOMIC_ACQUIRE, "agent"); asm volatile("s_waitcnt vmcnt(0)" ::: "memory"); }
    __syncthreads();
}

struct Args {
    const float *x, *mem, *g_mix, *w_in, *w_pool, *pool_scale, *conv_w, *w_out, *g_xattn, *g_mem, *w_q, *w_k, *w_v, *w_o, *g_moe, *w_router, *b_router, *w_gate_up, *b_gate_up, *w_down, *b_down, *g_final;
    float* out; unsigned char* ws; int ph_lo, ph_hi, rep_phase, pad_;
};

__device__ __forceinline__ void transpose_item(const float* W, int ldw, int K, bf16_t* WT, int k0, int srccol0, int n0, const float* g, LAS float* scr, int lane) {
#pragma unroll 8
    for (int i = 0; i < 32; ++i) { const int kk = 2 * i + (lane >> 5); scr[kk * 33 + (lane & 31)] = W[(size_t)(k0 + kk) * ldw + srccol0 + (lane & 31)]; }
    LDS_WAIT(); asm volatile("" ::: "memory");
    const int c = lane & 7;
    float gs[8];
#pragma unroll
    for (int q = 0; q < 8; ++q) gs[q] = g ? g[k0 + 8 * c + q] : 1.0f;
#pragma unroll
    for (int j = 0; j < 4; ++j) { const int n = (lane >> 3) + 8 * j; const LAS float* s = scr + (8 * c) * 33 + n;
        u32x4 o; o.x = cvt_pk_bf16(s[0 * 33] * gs[0], s[1 * 33] * gs[1]); o.y = cvt_pk_bf16(s[2 * 33] * gs[2], s[3 * 33] * gs[3]); o.z = cvt_pk_bf16(s[4 * 33] * gs[4], s[5 * 33] * gs[5]); o.w = cvt_pk_bf16(s[6 * 33] * gs[6], s[7 * 33] * gs[7]);
        *(u32x4*)(WT + (size_t)(n0 + n) * K + k0 + 8 * c) = o; }
    LDS_WAIT(); asm volatile("" ::: "memory");
}
__device__ __forceinline__ void transpose_item_f8(const float* W, int ldw, int K, unsigned char* WT, int k0, int srccol0, int n0, const float* g, float scale, LAS float* scr, int lane) {
#pragma unroll 8
    for (int i = 0; i < 32; ++i) { const int kk = 2 * i + (lane >> 5); scr[kk * 33 + (lane & 31)] = W[(size_t)(k0 + kk) * ldw + srccol0 + (lane & 31)]; }
    LDS_WAIT(); asm volatile("" ::: "memory");
    const int c = lane & 7;
    float gs[8];
#pragma unroll
    for (int q = 0; q < 8; ++q) gs[q] = (g ? g[k0 + 8 * c + q] : 1.0f) * scale;
#pragma unroll
    for (int j = 0; j < 4; ++j) { const int n = (lane >> 3) + 8 * j; const LAS float* s = scr + (8 * c) * 33 + n;
        u32x2 o; o.x = pk4_fp8(s[0 * 33] * gs[0], s[1 * 33] * gs[1], s[2 * 33] * gs[2], s[3 * 33] * gs[3]); o.y = pk4_fp8(s[4 * 33] * gs[4], s[5 * 33] * gs[5], s[6 * 33] * gs[6], s[7 * 33] * gs[7]);
        *(u32x2*)(WT + (size_t)(n0 + n) * K + k0 + 8 * c) = o; }
    LDS_WAIT(); asm volatile("" ::: "memory");
}
__device__ __forceinline__ void rms_row_to_bf16(const float* xrow, const float* g, bf16_t* orow, int lane) {
    const f32x4* xr = (const f32x4*)xrow + lane; const f32x4* gr = (const f32x4*)g + lane;
    f32x4 v[4]; float s = 0.f;
#pragma unroll
    for (int j = 0; j < 4; ++j) { v[j] = xr[64 * j]; s += (v[j][0] * v[j][0] + v[j][1] * v[j][1]) + (v[j][2] * v[j][2] + v[j][3] * v[j][3]); }
    const float rstd = 1.0f / sqrtf(wave_sum(s) * (1.0f / D) + RMS_EPS);
    u32x2* o8 = (u32x2*)orow + lane;
#pragma unroll
    for (int j = 0; j < 4; ++j) { const f32x4 gv = gr[64 * j]; u32x2 w; w.x = cvt_pk_bf16(v[j][0] * rstd * gv[0], v[j][1] * rstd * gv[1]); w.y = cvt_pk_bf16(v[j][2] * rstd * gv[2], v[j][3] * rstd * gv[3]); o8[64 * j] = w; }
}
constexpr int CVT_PITCH = 144;
__device__ __forceinline__ void flush_rows128(LAS unsigned char* scr, unsigned char* dst0, size_t row_stride, int lane) {
    LDS_WAIT(); asm volatile("" ::: "memory");
#pragma unroll
    for (int j = 0; j < 8; ++j) { const int r = 8 * j + (lane >> 3), ch = lane & 7; const u32x4 v = *(const LAS u32x4*)(scr + r * CVT_PITCH + ch * 16); *(u32x4*)(dst0 + (size_t)r * row_stride + ch * 16) = v; }
    LDS_WAIT(); asm volatile("" ::: "memory");
}
template <bool F8>
__device__ __forceinline__ void cvt_block(const float* W, int ldw, int K, void* WT, int k0, int srccol0, int n0, const float* g, float scale, int lane, LAS unsigned char* scr) {
    const float* src = W + (size_t)k0 * ldw + srccol0 + lane;
    float v[64];
#pragma unroll
    for (int q = 0; q < 64; ++q) v[q] = src[(size_t)q * ldw];
#pragma unroll
    for (int q = 0; q < 64; ++q) v[q] *= (g ? g[k0 + q] : 1.0f) * scale;
    if constexpr (F8) { u32x4* dst = (u32x4*)((unsigned char*)WT + (size_t)(n0 + lane) * K + k0);
#pragma unroll
        for (int c = 0; c < 4; ++c) { u32x4 o; o.x = pk4_fp8(v[16 * c], v[16 * c + 1], v[16 * c + 2], v[16 * c + 3]); o.y = pk4_fp8(v[16 * c + 4], v[16 * c + 5], v[16 * c + 6], v[16 * c + 7]);
            o.z = pk4_fp8(v[16 * c + 8], v[16 * c + 9], v[16 * c + 10], v[16 * c + 11]); o.w = pk4_fp8(v[16 * c + 12], v[16 * c + 13], v[16 * c + 14], v[16 * c + 15]); dst[c] = o; }
    } else {
#pragma unroll
        for (int c = 0; c < 8; ++c) { u32x4 o; o.x = cvt_pk_bf16(v[8 * c], v[8 * c + 1]); o.y = cvt_pk_bf16(v[8 * c + 2], v[8 * c + 3]); o.z = cvt_pk_bf16(v[8 * c + 4], v[8 * c + 5]); o.w = cvt_pk_bf16(v[8 * c + 6], v[8 * c + 7]);
            *(LAS u32x4*)(scr + lane * CVT_PITCH + c * 16) = o; }
        flush_rows128(scr, (unsigned char*)((bf16_t*)WT + (size_t)n0 * K + k0), (size_t)K * 2, lane);
    }
}
struct CvtItem { const float* src; unsigned char* dst; const float* g; int ldw; float scale; };
__device__ __forceinline__ void cvt_load64(float (&v)[64], const CvtItem& it) {
#pragma unroll
    for (int q = 0; q < 64; ++q) v[q] = it.src[(size_t)q * it.ldw];
}
__device__ __forceinline__ void cvt_pack64_f8(const float (&v)[64], const CvtItem& it, LAS unsigned char* p) {
#pragma unroll
    for (int c = 0; c < 4; ++c) { float w[16];
#pragma unroll
        for (int q = 0; q < 16; ++q) w[q] = v[16 * c + q] * ((it.g ? it.g[16 * c + q] : 1.0f) * it.scale);
        u32x4 o; o.x = pk4_fp8(w[0], w[1], w[2], w[3]); o.y = pk4_fp8(w[4], w[5], w[6], w[7]); o.z = pk4_fp8(w[8], w[9], w[10], w[11]); o.w = pk4_fp8(w[12], w[13], w[14], w[15]);
        *(LAS u32x4*)(p + c * 16) = o; }
}
template <bool RAW>
__device__ __forceinline__ void rms_rows4_to_bf16(const float* x0, const float* g, bf16_t* o0, float* rstd_out, int lane) {
    f32x4 v[4][4]; float ssq[4];
#pragma unroll
    for (int r = 0; r < 4; ++r)
#pragma unroll
        for (int j = 0; j < 4; ++j) v[r][j] = ((const f32x4*)(x0 + (size_t)r * D))[2 * lane + (j & 1) + 128 * (j >> 1)];
#pragma unroll
    for (int r = 0; r < 4; ++r) { float s = 0.f;
#pragma unroll
        for (int j = 0; j < 4; ++j) s += (v[r][j][0] * v[r][j][0] + v[r][j][1] * v[r][j][1]) + (v[r][j][2] * v[r][j][2] + v[r][j][3] * v[r][j][3]);
        ssq[r] = 1.0f / sqrtf(wave_sum(s) * (1.0f / D) + RMS_EPS); }
#pragma unroll
    for (int jp = 0; jp < 2; ++jp) { const f32x4 ga = ((const f32x4*)g)[2 * lane + 128 * jp], gb = ((const f32x4*)g)[2 * lane + 1 + 128 * jp];
#pragma unroll
        for (int r = 0; r < 4; ++r) { const float rs = RAW ? 1.0f : ssq[r]; const f32x4 a = v[r][2 * jp], b = v[r][2 * jp + 1]; u32x4 w;
            w.x = cvt_pk_bf16(a[0] * rs * (RAW ? 1.0f : ga[0]), a[1] * rs * (RAW ? 1.0f : ga[1])); w.y = cvt_pk_bf16(a[2] * rs * (RAW ? 1.0f : ga[2]), a[3] * rs * (RAW ? 1.0f : ga[3]));
            w.z = cvt_pk_bf16(b[0] * rs * (RAW ? 1.0f : gb[0]), b[1] * rs * (RAW ? 1.0f : gb[1])); w.w = cvt_pk_bf16(b[2] * rs * (RAW ? 1.0f : gb[2]), b[3] * rs * (RAW ? 1.0f : gb[3]));
            ((u32x4*)(o0 + (size_t)r * D))[lane + 64 * jp] = w; } }
    if constexpr (RAW) { if (lane < 4) rstd_out[lane] = ssq[lane]; }
}
__device__ __forceinline__ void expert_stream(const Args& A, LAS unsigned char* lds, int cu, int G, int wave, int lane_in, int k_lo, int k_hi) {
    int lane = lane_in;
    asm volatile("" : "+v"(lane));
    LAS unsigned char* scr = lds + wave * 16384;
    const int gw = cu * NWAVES + wave, NGW = G * NWAVES;
    unsigned char* ws = A.ws;
    constexpr int B_GU = (D / 64) * (2 * DFF / 64), B_DN = (DFF / 64) * (D / 64), NT_E = NEXP * (B_GU + B_DN);
#define EXPERT_ITEM(it_, dst_) do { if ((it_) < NEXP * B_GU) { const int e = (it_) / B_GU, r = (it_) % B_GU, kb = r % 16, nb = r / 16, rho0 = 64 * nb, pn = rho0 >> 8, bj = (rho0 >> 7) & 1, cc = rho0 & 127; \
        (dst_).src = A.w_gate_up + (size_t)e * D * 2 * DFF + (size_t)(64 * kb) * (2 * DFF) + bj * DFF + 128 * pn + cc + lane; (dst_).ldw = 2 * DFF; (dst_).g = A.g_moe + 64 * kb; (dst_).scale = bj ? W8_SCALE : W8_SCALE * GLU_C; \
        (dst_).dst = ws + WS_WGU + (size_t)e * 2 * DFF * D + (size_t)rho0 * D + 64 * kb; } \
      else { const int i2 = (it_) - NEXP * B_GU, e = i2 / B_DN, r = i2 % B_DN, kb = r % 16, nb = r / 16; \
        (dst_).src = A.w_down + (size_t)e * DFF * D + (size_t)(64 * kb) * D + 64 * nb + lane; (dst_).ldw = D; (dst_).g = nullptr; (dst_).scale = W8_SCALE / GLU_C; \
        (dst_).dst = ws + WS_WD + (size_t)e * D * DFF + (size_t)(64 * nb) * DFF + 64 * kb; } } while (0)
    { float va[64], vb[64]; CvtItem ia, ib; int sit = gw + k_lo * NGW; const int send = (k_hi * NGW < NT_E / 2) ? k_hi * NGW : NT_E / 2;
      if (sit < send) { EXPERT_ITEM(2 * sit, ia); EXPERT_ITEM(2 * sit + 1, ib); cvt_load64(va, ia); cvt_load64(vb, ib);
          while (true) { unsigned char* const dst = ia.dst; const int nx = sit + NGW; const bool more = nx < send;
              cvt_pack64_f8(va, ia, scr + lane * CVT_PITCH);
              if (more) { EXPERT_ITEM(2 * nx, ia); cvt_load64(va, ia); }
              cvt_pack64_f8(vb, ib, scr + lane * CVT_PITCH + 64);
              flush_rows128(scr, dst, (size_t)D, lane);
              if (!more) break;
              EXPERT_ITEM(2 * nx + 1, ib); cvt_load64(vb, ib); sit = nx; } } }
#undef EXPERT_ITEM
}
__device__ __forceinline__ void p0_prologue(const Args& A, LAS unsigned char* lds, int cu, int G, int wave, int lane_in) {
    int lane = lane_in;
    LAS unsigned char* scr = lds + wave * 16384;
    const int gw = cu * NWAVES + wave, NGW = G * NWAVES;
    unsigned char* ws = A.ws;
    asm volatile("" : "+v"(lane));
    constexpr int B_IN = (D / 64) * (INW / 64), B_SQ = (D / 64) * (D / 64);
    for (int it = gw; it < B_IN + 5 * B_SQ; it += NGW) {
        int r = it;
        if (r < B_IN) { const int rho0 = 64 * (r % 32); int src = rho0;
            if (rho0 >= 1024) { const int q = rho0 - 1024; src = 1024 + ((q >> 7) & 1) * CONVW + 128 * (q >> 8) + (q & 127); }
            cvt_block<false>(A.w_in, INW, D, ws + WS_WIN, 64 * (r / 32), src, rho0, A.g_mix, 1.0f, lane, scr); continue; } r -= B_IN;
        const int which = r / B_SQ; r %= B_SQ; const int k0 = 64 * (r / 16), n0 = 64 * (r % 16);
        if (which == 0) cvt_block<false>(A.w_out, D, D, (k0 < POOLW) ? ws + WS_WOUT : ws + WS_WC, k0, n0, n0, nullptr, 1.0f, lane, scr);
        else if (which == 1) { }
        else if (which == 2) cvt_block<false>(A.w_k, D, D, ws + WS_WK, k0, n0, n0, nullptr, 1.0f, lane, scr);
        else if (which == 3) cvt_block<false>(A.w_v, D, D, ws + WS_WV, k0, n0, n0, nullptr, 1.0f, lane, scr);
        else cvt_block<false>(A.w_o, D, D, ws + WS_WO, k0, n0, n0, nullptr, 1.0f, lane, scr);
    }
    { const int gt = gw * 64 + lane, NT = NGW * 64; bf16_t* wpb = (bf16_t*)(ws + WS_WPB);
      for (int i = gt; i < 2 * 256 * 256; i += NT) { const int pn = i >> 16, kl = (i >> 8) & 255, jl = i & 255; float v = 0.f;
          if ((kl >> 7) == (jl >> 7)) v = A.w_pool[((size_t)(2 * pn + (kl >> 7)) * 128 + (kl & 127)) * 128 + (jl & 127)] * A.pool_scale[256 * pn + jl];
          wpb[i] = (bf16_t)(cvt_pk_bf16(v, 0.f) & 0xffffu); }
      { u32x2* wq = (u32x2*)(ws + WS_WQ);
        for (int i = gt; i < D * D / 4; i += NT) { const f32x4 w = ((const f32x4*)A.w_q)[i]; const float g = A.g_xattn[i >> 8]; u32x2 o; o.x = cvt_pk_bf16(w[0] * g, w[1] * g); o.y = cvt_pk_bf16(w[2] * g, w[3] * g); wq[i] = o; } }
      bf16_t* wrt = (bf16_t*)(ws + WS_WRT);
      for (int i = gt; i < NEXP * D; i += NT) { const int e = i >> 10, k = i & 1023; const float w = A.g_moe[k] * A.w_router[(size_t)k * NEXP + e];
          const unsigned hi = cvt_pk_bf16(w, 0.f) & 0xffffu; const float r = w - __uint_as_float(hi << 16);
          wrt[i] = (bf16_t)hi; wrt[NEXP * D + i] = (bf16_t)(cvt_pk_bf16(r, 0.f) & 0xffffu); } }
    for (int m = gw * 4; m < MTOK; m += NGW * 4) rms_rows4_to_bf16<true>(A.x + (size_t)m * D, A.g_mix, (bf16_t*)(ws + WS_XN) + (size_t)m * D, (float*)(ws + WS_RSTD0) + m, lane);
    for (int m = gw * 4; m < MROWS; m += NGW * 4) rms_rows4_to_bf16<false>(A.mem + (size_t)m * D, A.g_mem, (bf16_t*)(ws + WS_MN) + (size_t)m * D, nullptr, lane);
}

__device__ __forceinline__ void ld8(const bf16_t* p, float (&f)[8]) { const u32x4 w = *(const u32x4*)p; f[0] = bflo(w.x); f[1] = bfhi(w.x); f[2] = bflo(w.y); f[3] = bfhi(w.y); f[4] = bflo(w.z); f[5] = bfhi(w.z); f[6] = bflo(w.w); f[7] = bfhi(w.w); }
__device__ __forceinline__ void st8(bf16_t* p, const float (&f)[8]) { u32x4 w; w.x = cvt_pk_bf16(f[0], f[1]); w.y = cvt_pk_bf16(f[2], f[3]); w.z = cvt_pk_bf16(f[4], f[5]); w.w = cvt_pk_bf16(f[6], f[7]); *(u32x4*)p = w; }
constexpr int RUNF = 16;
__device__ __forceinline__ void p2_mixers(const Args& A, int cu, int G, int wave, int lane) {
    const bf16_t* proj = (const bf16_t*)(A.ws + WS_PROJ); bf16_t* mixa = (bf16_t*)(A.ws + WS_MIXA);
    unsigned* ctr = (unsigned*)(A.ws + WS_CTL) + 1024;
    for (;;) { unsigned run_ = 0u; if (lane == 0) run_ = __hip_atomic_fetch_add(ctr, 1u, __ATOMIC_RELAXED, __HIP_MEMORY_SCOPE_AGENT); const int run = __builtin_amdgcn_readfirstlane((int)run_); if (run >= MTOK / RUNF) break;
        const int row0 = run * RUNF, t0 = row0 % SEQ;
        { const int c0 = 8 * lane, w = 2 << (lane >> 4); const bf16_t* up = proj + (size_t)row0 * PROJW + c0;
          const bf16_t* gbp = proj + (size_t)row0 * PROJW + POOLW + c0; const bf16_t* zp = gbp + CONVW;
          float sum[8], w0[8], w1[8], w2[8], z2[8], z1[8];
#pragma unroll
          for (int q = 0; q < 8; ++q) { sum[q] = 0.f; w0[q] = A.conv_w[c0 + q]; w1[q] = A.conv_w[CONVW + c0 + q]; w2[q] = A.conv_w[2 * CONVW + c0 + q]; z2[q] = 0.f; z1[q] = 0.f; }
          if (t0 > 0) { ld8(zp - (size_t)2 * PROJW, z2); ld8(zp - (size_t)PROJW, z1);
              u32x4 hw_[15];
#pragma unroll
              for (int j = 1; j < 16; ++j) { hw_[j - 1] = (u32x4){0u, 0u, 0u, 0u}; if (j < w) hw_[j - 1] = *(const u32x4*)(up - (size_t)j * PROJW); }
#pragma unroll
              for (int j = 1; j < 16; ++j) { const u32x4 x = hw_[j - 1]; sum[0] += bflo(x.x); sum[1] += bfhi(x.x); sum[2] += bflo(x.y); sum[3] += bfhi(x.y); sum[4] += bflo(x.z); sum[5] += bfhi(x.z); sum[6] += bflo(x.w); sum[7] += bfhi(x.w); } }
#pragma unroll 8
          for (int i = 0; i < RUNF; ++i) { const int t = t0 + i; float cur[8], d[8], z0[8], g[8], y[8];
              ld8(up + (size_t)i * PROJW, cur); ld8(zp + (size_t)i * PROJW, z0); ld8(gbp + (size_t)i * PROJW, g);
              const float inv = 1.0f / (float)((t + 1 < w) ? (t + 1) : w);
#pragma unroll
              for (int q = 0; q < 8; ++q) { sum[q] += cur[q]; d[q] = sum[q] * inv - cur[q]; }
              st8(mixa + (size_t)(row0 + i) * D + c0, d);
#pragma unroll
              for (int q = 0; q < 8; ++q) { y[q] = g[q] * (w0[q] * z2[q] + w1[q] * z1[q] + w2[q] * z0[q]); z2[q] = z1[q]; z1[q] = z0[q]; }
              st8(mixa + (size_t)(row0 + i) * D + POOLW + c0, y);
              if (t - w + 1 >= 0) { float old[8]; ld8(up + (ptrdiff_t)(i - w + 1) * PROJW, old);
#pragma unroll
                  for (int q = 0; q < 8; ++q) sum[q] -= old[q]; } } }
    }
}

typedef float f32x16 __attribute__((ext_vector_type(16)));
constexpr int WR_PITCH = 1032;
__device__ __forceinline__ void p9_router(const Args& A, LAS unsigned char* lds, int cu, int wave, int lane) {
    const bf16_t* h2 = (const bf16_t*)(A.ws + WS_H1B); const bf16_t* wrt = (const bf16_t*)(A.ws + WS_WRT);
    float* rstd2 = (float*)(A.ws + WS_RSTD2); int* etok = (int*)(A.ws + WS_ETOK); float* gtok = (float*)(A.ws + WS_GTOK); int* cnt = (int*)(A.ws + WS_CNT);
    LAS int* lcnt = (LAS int*)(lds + MISC_OFF + 256);
    LAS bf16_t* WL = (LAS bf16_t*)lds;
    if (threadIdx.x < NEXP) lcnt[threadIdx.x] = 0;
    for (int i = threadIdx.x; i < 2 * NEXP * (D / 8); i += NTHREADS) { const int row = i >> 7, ch = i & 127; *(LAS u32x4*)(WL + row * WR_PITCH + ch * 8) = *(const u32x4*)(wrt + (size_t)row * D + ch * 8); }
    __syncthreads();
    const int t = lane & 31, h = lane >> 5; const int tok = cu * 256 + wave * 32 + t;
    const bf16_t* xp = h2 + (size_t)tok * D + 16 * h;
    const LAS bf16_t* wh = WL + t * WR_PITCH + 16 * h; const LAS bf16_t* wl = wh + NEXP * WR_PITCH;
    f32x16 acc;
#pragma unroll
    for (int r = 0; r < 16; ++r) acc[r] = 0.f;
    float ss = 0.f;
#pragma unroll 4
    for (int s = 0; s < 32; ++s) {
        const u32x4 x0 = *(const u32x4*)(xp + 32 * s), x1 = *(const u32x4*)(xp + 32 * s + 8);
#pragma unroll
        for (int q = 0; q < 4; ++q) { const float a = bflo(x0[q]), b = bfhi(x0[q]), c = bflo(x1[q]), d = bfhi(x1[q]); ss += (a * a + b * b) + (c * c + d * d); }
        const bf16x8 b0 = __builtin_bit_cast(bf16x8, x0), b1 = __builtin_bit_cast(bf16x8, x1);
        const bf16x8 ah0 = *(const LAS bf16x8*)(wh + 32 * s), ah1 = *(const LAS bf16x8*)(wh + 32 * s + 8), al0 = *(const LAS bf16x8*)(wl + 32 * s), al1 = *(const LAS bf16x8*)(wl + 32 * s + 8);
        acc = __builtin_amdgcn_mfma_f32_32x32x16_bf16(ah0, b0, acc, 0, 0, 0); acc = __builtin_amdgcn_mfma_f32_32x32x16_bf16(al0, b0, acc, 0, 0, 0);
        acc = __builtin_amdgcn_mfma_f32_32x32x16_bf16(ah1, b1, acc, 0, 0, 0); acc = __builtin_amdgcn_mfma_f32_32x32x16_bf16(al1, b1, acc, 0, 0, 0);
    }
    ss += __shfl_xor(ss, 32);
    const float rs = 1.0f / sqrtf(ss * (1.0f / D) + RMS_EPS);
    float lgA[16], lgB[16];
#pragma unroll
    for (int r = 0; r < 16; ++r) { const float mine = acc[r], other = __shfl_xor(mine, 32); lgA[r] = h ? other : mine; lgB[r] = h ? mine : other; }
#pragma unroll
    for (int e = 0; e < 32; ++e) { const int r = (e & 3) + 4 * (e >> 3); const float b = A.b_router[e]; if ((e >> 2) & 1) lgB[r] = lgB[r] * rs + b; else lgA[r] = lgA[r] * rs + b; }
    float tv[4]; int ti[4];
#pragma unroll
    for (int k = 0; k < 4; ++k) { float best = -INFINITY; int bi = 0;
#pragma unroll
        for (int e = 0; e < 32; ++e) { const int r = (e & 3) + 4 * (e >> 3); const float v = ((e >> 2) & 1) ? lgB[r] : lgA[r]; if (v > best) { best = v; bi = e; } }
        tv[k] = best; ti[k] = bi;
#pragma unroll
        for (int e = 0; e < 32; ++e) { const int r = (e & 3) + 4 * (e >> 3); if (bi == e) { if ((e >> 2) & 1) lgB[r] = -INFINITY; else lgA[r] = -INFINITY; } } }
    const float e1 = __expf(tv[1] - tv[0]), e2 = __expf(tv[2] - tv[0]), e3 = __expf(tv[3] - tv[0]); const float inv = 1.0f / (1.0f + e1 + e2 + e3);
    if (h == 0) { rstd2[tok] = rs;
        *(int4*)(etok + (size_t)tok * 4) = make_int4(ti[0], ti[1], ti[2], ti[3]);
        *(f32x4*)(gtok + (size_t)tok * 4) = (f32x4){inv, e1 * inv, e2 * inv, e3 * inv};
        atomicAdd((int*)&lcnt[ti[0]], 1); atomicAdd((int*)&lcnt[ti[1]], 1); atomicAdd((int*)&lcnt[ti[2]], 1); atomicAdd((int*)&lcnt[ti[3]], 1); }
    __syncthreads();
    if (threadIdx.x < NEXP) cnt[cu * NEXP + threadIdx.x] = lcnt[threadIdx.x];
}

__device__ __forceinline__ void p10_scatter(const Args& A, LAS unsigned char* lds, int cu, int G) {
    const int* cnt = (const int*)(A.ws + WS_CNT); const int* etok = (const int*)(A.ws + WS_ETOK); const float* gtok = (const float*)(A.ws + WS_GTOK);
    int* slot_of_tok = (int*)(A.ws + WS_SLOT_OF_TOK); int* tok_of_slot = (int*)(A.ws + WS_TOK_OF_SLOT); float* gate_of_slot = (float*)(A.ws + WS_GATE_OF_SLOT); int* pstart = (int*)(A.ws + WS_PSTART);
    float* rs_slot = (float*)(A.ws + WS_RS_SLOT); const float* rstd2 = (const float*)(A.ws + WS_RSTD2);
    LAS int* sll = (LAS int*)lds;
    LAS int* ptot = (LAS int*)(lds + MISC_OFF + 512);
    LAS int* pbef = ptot + 512;
    LAS int* base = pbef + 512;
    LAS int* lcnt = base + 32;
    LAS int* pst = lcnt + 32;
    LAS int* tot = pst + 40;
    const int t = threadIdx.x;
    { const int e = t & 31, part = t >> 5; int a = 0, b = 0;
      for (int c2 = part * 16; c2 < part * 16 + 16; ++c2) { if (c2 < G) { const int v = cnt[c2 * NEXP + e]; a += v; if (c2 < cu) b += v; } }
      ptot[part * 32 + e] = a; pbef[part * 32 + e] = b; }
    if (t < NEXP) lcnt[t] = 0;
    __syncthreads();
    if (t < NEXP) { int a = 0, b = 0; for (int p = 0; p < 16; ++p) { a += ptot[p * 32 + t]; b += pbef[p * 32 + t]; } tot[t] = a; base[t] = b; }
    __syncthreads();
    if (t == 0) { int s = 0; for (int e = 0; e < NEXP; ++e) { pst[e] = s; s += ((tot[e] + 255) >> 8) << 8; } pst[NEXP] = s; }
    __syncthreads();
    if (t < 256) { const int tok = cu * 256 + t; const int4 ev = *(const int4*)(etok + (size_t)tok * 4); const f32x4 gv = *(const f32x4*)(gtok + (size_t)tok * 4);
        const int es[4] = {ev.x, ev.y, ev.z, ev.w}; int sl[4];
        const float rs = rstd2[tok];
#pragma unroll
        for (int k = 0; k < 4; ++k) { const int e = es[k]; const int rank = atomicAdd((int*)&lcnt[e], 1); const int slot = pst[e] + base[e] + rank; sl[k] = slot; tok_of_slot[slot] = tok; gate_of_slot[slot] = gv[k]; rs_slot[slot] = rs; sll[t * 4 + k] = slot; }
        *(int4*)(slot_of_tok + (size_t)tok * 4) = make_int4(sl[0], sl[1], sl[2], sl[3]); }
    if (cu < NEXP) { const int e = cu; for (int s = pst[e] + tot[e] + t; s < pst[e + 1]; s += NTHREADS) { tok_of_slot[s] = 0; gate_of_slot[s] = 0.f; rs_slot[s] = 0.f; } }
    if (cu == 0 && t <= NEXP) pstart[t] = pst[t];
}

__device__ __forceinline__ void p12_final(const Args& A, float* dst, int cu, int wave, int lane) {
    const int* slot_of_tok = (const int*)(A.ws + WS_SLOT_OF_TOK); const unsigned char* Y = A.ws + WS_Y; const bf16_t* h2 = (const bf16_t*)(A.ws + WS_H1B);
    f32x4 gf[4];
#pragma unroll
    for (int j = 0; j < 4; ++j) gf[j] = *(const f32x4*)(A.g_final + 256 * j + 4 * lane);
    int4 sln[4];
#pragma unroll
    for (int r = 0; r < 4; ++r) sln[r] = *(const int4*)(slot_of_tok + (size_t)(cu * 256 + wave * 32 + r) * 4);
    for (int i = 0; i < 32; i += 4) { const int tok0 = cu * 256 + wave * 32 + i;
        u32x2 hv[4][4]; unsigned yv[4][4][4]; int4 slc[4];
#pragma unroll
        for (int r = 0; r < 4; ++r) { slc[r] = sln[r]; if (i + 4 < 32) sln[r] = *(const int4*)(slot_of_tok + (size_t)(tok0 + 4 + r) * 4); }
#pragma unroll
        for (int r = 0; r < 4; ++r) { const int4 sl = slc[r]; const int sls[4] = {sl.x, sl.y, sl.z, sl.w};
#pragma unroll
            for (int j = 0; j < 4; ++j) hv[r][j] = *(const u32x2*)(h2 + (size_t)(tok0 + r) * D + 256 * j + 4 * lane);
#pragma unroll
            for (int k = 0; k < 4; ++k)
#pragma unroll
                for (int j = 0; j < 4; ++j) yv[r][k][j] = *(const unsigned*)(Y + (size_t)sls[k] * D + 256 * j + 4 * lane); }
#pragma unroll
        for (int r = 0; r < 4; ++r) { float v[16];
#pragma unroll
            for (int j = 0; j < 4; ++j) { v[4 * j] = bflo(hv[r][j].x); v[4 * j + 1] = bfhi(hv[r][j].x); v[4 * j + 2] = bflo(hv[r][j].y); v[4 * j + 3] = bfhi(hv[r][j].y); }
            float ysum[16];
#pragma unroll
            for (int q = 0; q < 16; ++q) ysum[q] = 0.f;
#pragma unroll
            for (int k = 0; k < 4; ++k)
#pragma unroll
                for (int j = 0; j < 4; ++j) { const f32x2 lo = __builtin_amdgcn_cvt_pk_f32_fp8((int)yv[r][k][j], false), hi = __builtin_amdgcn_cvt_pk_f32_fp8((int)yv[r][k][j], true);
                    ysum[4 * j] += lo[0]; ysum[4 * j + 1] += lo[1]; ysum[4 * j + 2] += hi[0]; ysum[4 * j + 3] += hi[1]; }
            float s = 0.f;
#pragma unroll
            for (int q = 0; q < 16; ++q) { v[q] += ysum[q] * Y8_INV; s += v[q] * v[q]; }
            const float rs = 1.0f / sqrtf(wave_sum(s) * (1.0f / D) + RMS_EPS);
#pragma unroll
            for (int j = 0; j < 4; ++j) *(f32x4*)(dst + (size_t)(tok0 + r) * D + 256 * j + 4 * lane) = (f32x4){v[4 * j] * rs * gf[j][0], v[4 * j + 1] * rs * gf[j][1], v[4 * j + 2] * rs * gf[j][2], v[4 * j + 3] * rs * gf[j][3]}; } }
}

constexpr int N_PHASES = 14;
__device__ __forceinline__ Args load_args() {
    union { Args a; unsigned long long w[sizeof(Args) / 8]; } u;
#if defined(__HIP_DEVICE_COMPILE__)
    typedef __attribute__((address_space(4))) const unsigned long long cu64;
    const cu64* q = (const cu64*)__builtin_amdgcn_kernarg_segment_ptr(); asm volatile("" : "+s"(q));
#pragma unroll
    for (int i = 0; i < (int)(sizeof(Args) / 8); ++i) u.w[i] = q[i];
#endif
    return u.a;
}
__global__ void __launch_bounds__(NTHREADS, 2) mk_fwd(Args args_in) {
    extern __shared__ __attribute__((aligned(16))) unsigned char lds_raw[];
    LAS unsigned char* lds = (LAS unsigned char*)lds_raw;
    const int tid0 = threadIdx.x;
    const int G = gridDim.x, cu = blockIdx.x;
    unsigned char* ws = args_in.ws;
    for (int u = tid0; u < (LDS_BYTES - MISC_OFF) / 4; u += NTHREADS) ((LAS unsigned*)(lds + MISC_OFF))[u] = 0u;
    __syncthreads();
    XcdBarrier bar; bar.bar = (unsigned*)(ws + WS_CTL) + 4096; bar.x = 0; bar.st = nullptr;
    const bool one_launch = (args_in.ph_hi - args_in.ph_lo) > 1;
    if (one_launch) bar = xcd_barrier_post((unsigned*)(ws + WS_CTL) + 4096, (volatile LAS unsigned*)(lds + MISC_OFF + 32));
#define lo (load_args().ph_lo)
#define hi (load_args().ph_hi)
#define rep_phase (load_args().rep_phase)
#ifdef ONLY_PHASE
#define IN(k) ((k) == ONLY_PHASE && lo <= (k) && (k) < hi)
#else
#define IN(k) (lo <= (k) && (k) < hi)
#endif
#define SEAM(k) do { if (IN(k) && IN((k) + 1)) xcd_barrier(bar); } while (0)
#define SEAM_LOCAL(k) do { if (IN(k) && IN((k) + 1)) wg_self_sync(); } while (0)
    const float QSCALE = 0.0625f * 1.4426950408889634f;

    if (IN(0)) for (int rep_ = 0; rep_ < ((rep_phase == 0) ? 2 : 1); ++rep_) { const Args args = load_args(); p0_prologue(args, lds, cu, G, __builtin_amdgcn_readfirstlane(tid0 >> 6), tid0 & 63); }
    SEAM(0);
    int tid_l = tid0; asm volatile("" : "+v"(tid_l));
    const int tid = tid_l, lane = tid & 63, wave = __builtin_amdgcn_readfirstlane(tid >> 6);
#define EXPERT_SLICE(lo_, hi_) do { const Args ea_ = load_args(); __syncthreads(); expert_stream(ea_, lds, cu, G, wave, lane, lo_, hi_); __syncthreads(); } while (0)
    LAS int* utabd = (LAS int*)(lds + MISC_OFF + 3584);
#define BUILD_UTAB(nM_, nN_) do { __syncthreads(); if (tid < 128) { int pm_ = 0, pn_ = 0; const bool ok_ = pg8::static_order(tid, G, cu, nM_, nN_, pm_, pn_); utabd[tid] = ok_ ? (pm_ | (pn_ << 16)) : -1; } __syncthreads(); } while (0)
    const bool chain = one_launch && G == MTOK / 256 && bar.st[3] == 1u && bar.st[0] == 32u;
    const int vcu = chain ? (int)(bar.st[2] * 8u + bar.x) : cu;
    const int rtile = chain ? (int)(bar.x * 32u + bar.st[2]) : cu;
#define BUILD_UTAB_ROW(nM_, nN_) do { __syncthreads(); if (tid < 128) { int pm_ = 0, pn_ = 0; const bool ok_ = pg8::static_order(tid, G, vcu, nM_, nN_, pm_, pn_); utabd[tid] = ok_ ? (pm_ | (pn_ << 16)) : -1; } __syncthreads(); } while (0)
#define SEAM_CHAIN(k) do { if (IN(k) && IN((k) + 1)) { if (chain) xcd_local_barrier(bar); else xcd_barrier(bar); } } while (0)
    int two_ = 2; asm volatile("" : "+s"(two_));
    const bool odd_cu = cu & 1;
    if (IN(1)) for (int rep_ = 0; rep_ < ((rep_phase == 1) ? 2 : 1); ++rep_) { const Args args = load_args();
      _Pragma("nounroll") for (int t_ = 0; t_ < two_; ++t_) { if ((t_ == 0) == odd_cu) { EXPERT_SLICE(0, 2); } else {
        BUILD_UTAB(MTOK / 256, INW / 256);
        SchedDense S{utabd, nullptr, D * 2, D * 2, 0};
        EpiProj E{(bf16_t*)(ws + WS_PROJ), (const float*)(ws + WS_RSTD0)};
        pg8::gemm_phase<EpiProj, SchedDense, false, true, true>(lds, ws + WS_XN, ws + WS_WIN, D * 2, D * 2, D * 2, nullptr, S, E);
      } }
    }
    SEAM(1);
    if (IN(2)) for (int rep_ = 0; rep_ < ((rep_phase == 2) ? 2 : 1); ++rep_) { const Args args = load_args();
        for (int q = cu; q < (MROWS / 256) * 8; q += G) { const int pm = q >> 3, pn = q & 7;
            { SchedList S{pn, 1, (unsigned)pm * 256u * D * 2u, 256u * D * 2u, (char*)(ws + WS_KV) + ((size_t)pm * 256 * 2 * D + pn * 256) * 2};
              EpiStore E{2 * D}; pg8::gemm_phase<EpiStore, SchedList, false, false, true>(lds, ws + WS_MN, ws + WS_WK, D * 2, D * 2, D * 2, nullptr, S, E); }
            wg_self_sync();
            const int b = pm, h = pn & 3, bh = b * NHEAD + h;
            if (pn < 4) {
              SchedList S{0, 4, ((unsigned)b * 256u * 2u * D + (unsigned)h * HDIM) * 2u, 256u * D * 2u, (char*)(ws + WS_MT) + (size_t)bh * 256 * D, 0u, (size_t)256};
              EpiStore8 E{D}; pg8::gemm_phase<EpiStore8, SchedList, false, false, true>(lds, ws + WS_KV, ws + WS_WQ + (size_t)h * HDIM * 2, HDIM * 2, 2 * D * 2, D * 2, nullptr, S, E); }
            else {
              SchedList S{0, 4, (unsigned)h * HDIM * 2u, 0u, (char*)(ws + WS_NT) + ((size_t)b * D * D + h * HDIM), 256u * D * 2u, (size_t)256 * D};
              EpiStore8 E{D}; pg8::gemm_phase<EpiStore8, SchedList, false, false, true>(lds, ws + WS_WO, ws + WS_KV + ((size_t)b * 256 * 2 * D + D + h * HDIM) * 2, HDIM * 2, D * 2, 2 * D * 2, nullptr, S, E); } }
        for (int q = (G >= (MROWS / 256) * 8 + 8) ? cu - (MROWS / 256) * 8 : cu; q >= 0 && q < 8; q += G) { const int pmn = q >> 1, pn = q & 1;
            SchedList S{0, 1, ((unsigned)pmn * 256u * D + (unsigned)pn * 256u) * 2u, 0u, (char*)(ws + WS_WC) + ((size_t)pmn * 256 * D + pn * 256) * 2};
            EpiStore E{D}; pg8::gemm_phase<EpiStore, SchedList, false, false, true>(lds, ws + WS_WOUT, ws + WS_WPB + (size_t)pn * 256 * 256 * 2, 256 * 2, D * 2, 256 * 2, nullptr, S, E); }
        p2_mixers(args, cu, G, wave, lane);
    }
    SEAM(2);
    if (IN(4)) for (int rep_ = 0; rep_ < ((rep_phase == 4) ? 2 : 1); ++rep_) { const Args args = load_args();
      _Pragma("nounroll") for (int t_ = 0; t_ < two_; ++t_) { if ((t_ == 0) == odd_cu) { EXPERT_SLICE(2, 4); } else {
        BUILD_UTAB_ROW(MTOK / 256, D / 256);
        SchedDense S{utabd, nullptr, D * 2, D * 2, 0};
        EpiOutProj E{(const bf16_t*)(ws + WS_XN), (bf16_t*)(ws + WS_H1B), (float*)(ws + WS_SS1), ws + WS_H1Q};
        pg8::gemm_phase<EpiOutProj, SchedDense, false, true, true, false, true>(lds, ws + WS_MIXA, ws + WS_WC, D * 2, D * 2, D * 2, nullptr, S, E);
      } }
    }
    SEAM_CHAIN(4);
    if (IN(5)) for (int rep_ = 0; rep_ < ((rep_phase == 5) ? 2 : 1); ++rep_) { const Args args = load_args();
      _Pragma("nounroll") for (int t_ = 0; t_ < two_; ++t_) { if ((t_ == 0) == odd_cu) { EXPERT_SLICE(4, 5); } else {
        BUILD_UTAB_ROW(MTOK / 256, NHEAD);
        SchedScores S{utabd, (char*)(ws + WS_P)};
        EpiSoftmax E{D, (const float*)(ws + WS_SS1), QSCALE};
        pg8::gemm_phase<EpiSoftmax, SchedScores, false, true, true, true, true>(lds, ws + WS_H1Q, ws + WS_MT, D, D, D, nullptr, S, E);
      } }
    }
    SEAM_CHAIN(5);
    if (IN(8)) for (int rep_ = 0; rep_ < ((rep_phase == 8) ? 2 : 1); ++rep_) { const Args args = load_args();
      _Pragma("nounroll") for (int t_ = 0; t_ < two_; ++t_) { if ((t_ == 0) == odd_cu) { EXPERT_SLICE(5, 1024); } else {
        BUILD_UTAB_ROW(MTOK / 256, D / 256);
        SchedAttnOut S{utabd};
        EpiWo E{(const bf16_t*)(ws + WS_H1B), (bf16_t*)(ws + WS_H1B), ws + WS_H2B};
        pg8::gemm_phase<EpiWo, SchedAttnOut, false, true, true, true, true>(lds, ws + WS_P, ws + WS_NT, D, D, D, nullptr, S, E);
      } }
    }
    SEAM_CHAIN(8);
    if (IN(9)) for (int rep_ = 0; rep_ < ((rep_phase == 9) ? 2 : 1); ++rep_) { const Args args = load_args(); p9_router(args, lds, rtile, wave, lane); }
    SEAM(9);
    if (IN(10)) for (int rep_ = 0; rep_ < ((rep_phase == 10) ? 2 : 1); ++rep_) { const Args args = load_args(); p10_scatter(args, lds, cu, G); }
    SEAM(10);
    if (IN(11) || IN(12)) {
        LAS int* pst = (LAS int*)(lds + MISC_OFF + 1024);
        LAS unsigned char* tile_e = (LAS unsigned char*)(lds + MISC_OFF + 2048);
        const int* pstart = (const int*)(ws + WS_PSTART);
        if (tid <= NEXP) pst[tid] = pstart[tid];
        __syncthreads();
        const int T = pst[NEXP] >> 8;
        for (int tt = tid; tt < T; tt += NTHREADS) { int e = 0; for (int k = 1; k < NEXP; ++k) if (pst[k] <= (tt << 8)) e = k; tile_e[tt] = (unsigned char)e; }
        __syncthreads();
        LAS int* utab11 = (LAS int*)(lds + MISC_OFF + 3584); LAS int* utab12 = utab11 + 128;
        if (tid < 256) { const int i_ = tid & 127, nn_ = (tid < 128) ? 8 : 4; int pm_ = 0, pn_ = 0; bool ok_;
            if (chain) { const int x_ = (int)bar.x, t0_ = (x_ * T) >> 3, t1_ = ((x_ + 1) * T) >> 3;
                const int r_ = (int)bar.st[2], nu_ = ((t1_ - t0_) * nn_ - r_ + 31) >> 5;
                ok_ = pg8::plain_order((tid < 128) ? i_ : nu_ - 1 - i_, 32, r_, t1_ - t0_, nn_, pm_, pn_) && i_ < nu_; pm_ += t0_; }
            else ok_ = pg8::static_order(i_, G, cu, T, nn_, pm_, pn_);
            ((tid < 128) ? utab11 : utab12)[i_] = ok_ ? (pm_ | (pn_ << 11) | ((int)tile_e[pm_] << 14)) : -1; }
        __syncthreads();
        if (IN(11)) for (int rep_ = 0; rep_ < ((rep_phase == 11) ? 2 : 1); ++rep_) { const Args args = load_args();
            SchedMoe S{utab11, 2u * DFF * D, tile_e, 0u};
            EpiGateUp E{(const float*)(ws + WS_RS_SLOT), args.b_gate_up, ws + WS_ACT};
            pg8::gemm_phase<EpiGateUp, SchedMoe, true, true, true, true>(lds, ws + WS_H2B, ws + WS_WGU, D, D, D, (const int*)(ws + WS_TOK_OF_SLOT), S, E);
        }
        SEAM_CHAIN(11);
        if (IN(12)) for (int rep_ = 0; rep_ < ((rep_phase == 12) ? 2 : 1); ++rep_) { const Args args = load_args();
            SchedMoe S{utab12, (unsigned)D * DFF, tile_e, 256u * DFF};
            EpiDown E{(const float*)(ws + WS_GATE_OF_SLOT), args.b_down, ws + WS_Y};
            pg8::gemm_phase<EpiDown, SchedMoe, false, true, true, true, true>(lds, ws + WS_ACT, ws + WS_WD, DFF, DFF, DFF, nullptr, S, E);
        }
    }
    SEAM(12);
    if (IN(13)) for (int rep_ = 0; rep_ < ((rep_phase == 13) ? 2 : 1); ++rep_) { const Args args = load_args(); p12_final(args, args.out, cu, wave, lane); }
#undef IN
#undef SEAM
#undef SEAM_LOCAL
#undef SEAM_CHAIN
#undef BUILD_UTAB_ROW
#undef lo
#undef hi
#undef rep_phase
}

extern "C" void kernel_launch(void* const* d_in, const int* in_sizes, int n_in, void* d_out, int out_size, void* d_ws, size_t ws_size, hipStream_t stream) {
    static int grid = 0;
    if (grid == 0) {
        if (n_in != 22 || in_sizes[0] != MTOK * D || out_size != MTOK * D || ws_size < WS_END) { fprintf(stderr, "kernel_launch: unexpected shapes (n_in %d, in0 %d, out %d, ws %zu)\n", n_in, n_in > 0 ? in_sizes[0] : -1, out_size, ws_size); grid = -1; return; }
        int dev = 0, cus = 0, per_cu = 0;
        if (hipGetDevice(&dev) != hipSuccess || hipDeviceGetAttribute(&cus, hipDeviceAttributeMultiprocessorCount, dev) != hipSuccess) { grid = -1; return; }
        if (hipFuncSetAttribute((const void*)mk_fwd, hipFuncAttributeMaxDynamicSharedMemorySize, LDS_BYTES) != hipSuccess) { fprintf(stderr, "kernel_launch: hipFuncSetAttribute failed\n"); grid = -1; return; }
        if (hipOccupancyMaxActiveBlocksPerMultiprocessor(&per_cu, (const void*)mk_fwd, NTHREADS, LDS_BYTES) != hipSuccess || per_cu < 1) { fprintf(stderr, "kernel_launch: occupancy query says %d blocks per CU\n", per_cu); (void)hipGetLastError(); grid = -1; return; }
        grid = cus;
        if (grid != 256) fprintf(stderr, "kernel_launch: note: %d CUs\n", grid);
    }
    if (grid < 0) return;
    (void)hipMemsetAsync((char*)d_ws + WS_CTL, 0, CTL_ZERO_BYTES, stream);
    Args a{};
    const float** ap = (const float**)&a;
    for (int i = 0; i < 22; ++i) ap[i] = (const float*)d_in[i];
    a.out = (float*)d_out; a.ws = (unsigned char*)d_ws;
#ifdef PROBE_PHASE
    a.rep_phase = PROBE_PHASE;
#else
    a.rep_phase = -1;
#endif
#if MK_N_LAUNCHES == 1
    a.ph_lo = 0; a.ph_hi = N_PHASES;
    hipLaunchKernelGGL(mk_fwd, dim3(grid), dim3(NTHREADS), LDS_BYTES, stream, a);
#else
    for (int p = 0; p < N_PHASES; ++p) { a.ph_lo = p; a.ph_hi = p + 1; hipLaunchKernelGGL(mk_fwd, dim3(grid), dim3(NTHREADS), LDS_BYTES, stream, a); }
#endif
}
```
